# Optimizing an MI355X kernel written in HIP

```python
import math
import jax
import jax.numpy as jnp
from jax import lax
import numpy as np

D_MODEL = 1024
BATCH = 1
SEQ = 16384
DEPTH = 2
DEC_BATCH = 4
DEC_SEQ = 8192
PAST_LEN = 128

GRID_W = 64
HGRN_HEADS = 4
HGRN_KEY_DIM = 128
HGRN_VAL_DIM = 128
HGRN_WIDTH = HGRN_HEADS * HGRN_VAL_DIM
HGRN_CHUNK = 32
GQA_HEADS = 4
GQA_KV_HEADS = 2
GQA_GROUP = GQA_HEADS // GQA_KV_HEADS
GQA_HEAD_DIM = 64
GQA_WIDTH = GQA_HEADS * GQA_HEAD_DIM
DIFF_HEADS = 4
DIFF_HEAD_DIM = 32
DIFF_WIDTH = DIFF_HEADS * 2 * DIFF_HEAD_DIM
MIX_WIDTH = HGRN_WIDTH + GQA_WIDTH + DIFF_WIDTH
Q_BLOCK = 128
ROPE_THETA = 10000.0
NORM_EPS = 1e-6
SPLIT_SIZES = (
    HGRN_HEADS * HGRN_KEY_DIM,
    HGRN_HEADS * HGRN_KEY_DIM,
    HGRN_HEADS * HGRN_KEY_DIM,
    HGRN_WIDTH,
    HGRN_WIDTH,
    GQA_HEADS * GQA_HEAD_DIM,
    GQA_KV_HEADS * GQA_HEAD_DIM,
    GQA_KV_HEADS * GQA_HEAD_DIM,
    GQA_WIDTH,
    DIFF_HEADS * 2 * DIFF_HEAD_DIM,
    DIFF_HEADS * 2 * DIFF_HEAD_DIM,
    DIFF_WIDTH,
    DIFF_WIDTH,
)
IN_COLS = 4352

kernel_name = "hymba_hgrn2_axialgqa_diffattn_encoder"


def _rms(x, w):
    xf = x.astype(jnp.float32)
    y = xf * lax.rsqrt(jnp.mean(xf * xf, axis=-1, keepdims=True) + NORM_EPS)
    return (y * w.astype(jnp.float32)).astype(x.dtype)


def _rope_tables(pos, dim):
    inv = jnp.power(ROPE_THETA, -jnp.arange(0, dim, 2, dtype=jnp.float32) / dim)
    ang = pos[:, None] * inv[None, :]
    ang = jnp.concatenate([ang, ang], axis=-1)
    return jnp.cos(ang), jnp.sin(ang)


def _apply_rope(x, cos, sin):
    shape = (1, x.shape[1]) + (1,) * (x.ndim - 3) + (x.shape[-1],)
    c = cos.reshape(shape)
    s = sin.reshape(shape)
    xf = x.astype(jnp.float32)
    half = x.shape[-1] // 2
    rot = jnp.concatenate([-xf[..., half:], xf[..., :half]], axis=-1)
    return (xf * c + rot * s).astype(x.dtype)


def _gla_chunked(q, k, v, g):
    B, H, L, dk = q.shape
    dv = v.shape[-1]
    n = L // HGRN_CHUNK
    q = q.reshape(B, H, n, HGRN_CHUNK, dk)
    k = k.reshape(B, H, n, HGRN_CHUNK, dk)
    v = v.reshape(B, H, n, HGRN_CHUNK, dv)
    g = g.reshape(B, H, n, HGRN_CHUNK, dk)
    b = jnp.cumsum(g, axis=3)
    mid = HGRN_CHUNK // 2
    b_mid = b[:, :, :, mid:mid + 1]
    b_last = b[:, :, :, -1:]
    qm = q * jnp.exp(b - b_mid)
    km = k * jnp.exp(b_mid - b)
    a = jnp.einsum('bhntd,bhnsd->bhnts', qm, km)
    causal_in_chunk = jnp.tril(jnp.ones((HGRN_CHUNK, HGRN_CHUNK), dtype=bool))
    a = jnp.where(causal_in_chunk, a, 0.0)
    o_intra = jnp.einsum('bhnts,bhnse->bhnte', a, v)
    d_state = jnp.einsum('bhnsd,bhnse->bhnde', k * jnp.exp(b_last - b), v)
    chunk_decay = jnp.exp(b_last[:, :, :, 0, :])

    def step(S, inp):
        dec, ds = inp
        return dec[..., None] * S + ds, S

    S0 = jnp.zeros((B, H, dk, dv), dtype=jnp.float32)
    _, S_prev = lax.scan(step, S0, (jnp.moveaxis(chunk_decay, 2, 0), jnp.moveaxis(d_state, 2, 0)))
    S_prev = jnp.moveaxis(S_prev, 0, 2)
    o_inter = jnp.einsum('bhntd,bhnde->bhnte', q * jnp.exp(b), S_prev)
    return (o_intra + o_inter).reshape(B, H, L, dv)


def _hgrn2_branch(aq, af, afb, ai, lb, norm_w):
    B, L, _ = aq.shape

    def heads(t):
        return t.astype(jnp.float32).reshape(B, L, HGRN_HEADS, -1).transpose(0, 2, 1, 3)

    q = jax.nn.silu(heads(aq))
    v = heads(ai)
    out = None
    for direction, fx in enumerate((af, afb)):
        lbd = lb[direction].reshape(HGRN_HEADS, 1, HGRN_KEY_DIM)
        xf = heads(fx)
        g = jnp.logaddexp(jnp.log(lbd), jnp.log1p(-lbd) + jax.nn.log_sigmoid(xf))
        k = (1.0 - lbd) * jax.nn.sigmoid(-xf)
        if direction == 0:
            o = _gla_chunked(q, k, v, g)
        else:
            o = jnp.flip(_gla_chunked(jnp.flip(q, 2), jnp.flip(k, 2), jnp.flip(v, 2), jnp.flip(g, 2)), 2)
        out = o if out is None else out + o
    out = out.transpose(0, 2, 1, 3)
    out = _rms(out, norm_w.reshape(HGRN_HEADS, HGRN_VAL_DIM))
    return out.reshape(B, L, HGRN_WIDTH).astype(aq.dtype)


def _query_blocks(q):
    B, L = q.shape[:2]
    nb = L // Q_BLOCK
    return jnp.moveaxis(q.reshape((B, nb, Q_BLOCK) + q.shape[2:]), 1, 0)


def _unblock(o, B, L):
    o = jnp.moveaxis(o, 0, 1)
    return o.reshape((B, L) + o.shape[3:])


def _gqa_attention(q, k, v):
    B, L = q.shape[:2]
    scale = 1.0 / math.sqrt(GQA_HEAD_DIM)

    def blk(qi):
        s = jnp.einsum('bqkgd,bskd->bkgqs', qi, k).astype(jnp.float32) * scale
        p = jax.nn.softmax(s, axis=-1).astype(v.dtype)
        return jnp.einsum('bkgqs,bskd->bqkgd', p, v)

    o = lax.map(blk, _query_blocks(q))
    return _unblock(o, B, L)


def _diff_attention(q, k, v, lam):
    B, L = q.shape[:2]
    scale = 1.0 / math.sqrt(DIFF_HEAD_DIM)

    def blk(qi):
        s = jnp.einsum('bqhcd,bshcd->bhcqs', qi, k).astype(jnp.float32) * scale
        p = jax.nn.softmax(s, axis=-1)
        w = (p[:, :, 0] - lam * p[:, :, 1]).astype(v.dtype)
        return jnp.einsum('bhqs,bshe->bqhe', w, v)

    o = lax.map(blk, _query_blocks(q))
    return _unblock(o, B, L)


def _trunk(x, pre_norm_w, w_in, hgrn_lb, hgrn_norm_w, gqa_q_norm_w, gqa_k_norm_w,
           diff_lambda, diff_norm_w, w_out, post_norm_w):
    B, L, _ = x.shape
    rows = L // GRID_W
    pos = jnp.arange(L, dtype=jnp.float32)
    row_pos = jnp.repeat(jnp.arange(rows, dtype=jnp.float32), GRID_W)
    col_pos = jnp.tile(jnp.arange(GRID_W, dtype=jnp.float32), rows)
    half = GQA_HEAD_DIM // 2
    cos_r, sin_r = _rope_tables(row_pos, half)
    cos_c, sin_c = _rope_tables(col_pos, half)
    cos_1, sin_1 = _rope_tables(pos, DIFF_HEAD_DIM)

    lb_all = jnp.cumsum(jax.nn.softmax(hgrn_lb.astype(jnp.float32), axis=0), axis=0)
    lb_all = lb_all - lb_all[:1]

    split_idx = []
    acc = 0
    for s in SPLIT_SIZES[:-1]:
        acc += s
        split_idx.append(acc)

    def axial(t):
        return jnp.concatenate([_apply_rope(t[..., :half], cos_r, sin_r),
                                _apply_rope(t[..., half:], cos_c, sin_c)], axis=-1)

    for layer in range(DEPTH):
        h = _rms(x, pre_norm_w[layer])
        proj = jnp.einsum('bld,dc->blc', h, w_in[layer])
        (aq, af, afb, ai, ag, bq, bk, bv, bg, cq, ck, cv, cg) = jnp.split(proj, split_idx, axis=-1)

        a_out = _hgrn2_branch(aq, af, afb, ai, lb_all[layer], hgrn_norm_w[layer]) * jax.nn.silu(ag)

        q = _rms(bq.reshape(B, L, GQA_KV_HEADS, GQA_GROUP, GQA_HEAD_DIM), gqa_q_norm_w[layer])
        k = _rms(bk.reshape(B, L, GQA_KV_HEADS, GQA_HEAD_DIM), gqa_k_norm_w[layer])
        v = bv.reshape(B, L, GQA_KV_HEADS, GQA_HEAD_DIM)
        b_out = _gqa_attention(axial(q), axial(k), v).reshape(B, L, GQA_WIDTH) * jax.nn.silu(bg)

        lam_init = 0.8 - 0.6 * math.exp(-0.3 * layer)
        lp = diff_lambda[layer].astype(jnp.float32)
        lam = jnp.exp(jnp.sum(lp[0] * lp[1])) - jnp.exp(jnp.sum(lp[2] * lp[3])) + lam_init
        q = _apply_rope(cq.reshape(B, L, DIFF_HEADS, 2, DIFF_HEAD_DIM), cos_1, sin_1)
        k = _apply_rope(ck.reshape(B, L, DIFF_HEADS, 2, DIFF_HEAD_DIM), cos_1, sin_1)
        v = cv.reshape(B, L, DIFF_HEADS, 2 * DIFF_HEAD_DIM)
        o = _rms(_diff_attention(q, k, v, lam), diff_norm_w[layer]) * (1.0 - lam_init)
        c_out = o.reshape(B, L, DIFF_WIDTH) * jax.nn.silu(cg)

        mix = jnp.concatenate([a_out, b_out, c_out], axis=-1)
        y = jnp.einsum('blc,cd->bld', mix, w_out[layer])
        x = x + _rms(y, post_norm_w[layer])
    return x


def setup_inputs(seed: int = 0) -> dict:
    key = jax.random.key(seed)
    ks = jax.random.split(key, 13)
    f32 = jnp.float32
    return {
        "x_prompt": jax.random.normal(ks[0], (BATCH, SEQ, D_MODEL), f32),
        "x_sample": jax.random.normal(ks[1], (DEC_BATCH, DEC_SEQ, D_MODEL), f32),
        "pre_norm_w": 1.0 + 0.05 * jax.random.normal(ks[2], (DEPTH, D_MODEL), f32),
        "w_in": jax.random.normal(ks[3], (DEPTH, D_MODEL, IN_COLS), f32) * D_MODEL ** -0.5,
        "hgrn_lb": 0.1 * jax.random.normal(ks[4], (DEPTH, 2, HGRN_HEADS * HGRN_KEY_DIM), f32),
        "hgrn_norm_w": 1.0 + 0.05 * jax.random.normal(ks[5], (DEPTH, HGRN_WIDTH), f32),
        "gqa_q_norm_w": 1.0 + 0.05 * jax.random.normal(ks[6], (DEPTH, GQA_HEAD_DIM), f32),
        "gqa_k_norm_w": 1.0 + 0.05 * jax.random.normal(ks[7], (DEPTH, GQA_HEAD_DIM), f32),
        "diff_lambda": 0.1 * jax.random.normal(ks[8], (DEPTH, 4, DIFF_HEAD_DIM), f32),
        "diff_norm_w": 1.0 + 0.05 * jax.random.normal(ks[9], (DEPTH, 2 * DIFF_HEAD_DIM), f32),
        "w_out": jax.random.normal(ks[10], (DEPTH, MIX_WIDTH, D_MODEL), f32) * MIX_WIDTH ** -0.5,
        "post_norm_w": 1.0 + 0.05 * jax.random.normal(ks[11], (DEPTH, D_MODEL), f32),
    }


def reference(x_prompt, x_sample, pre_norm_w, w_in, hgrn_lb, hgrn_norm_w, gqa_q_norm_w,
              gqa_k_norm_w, diff_lambda, diff_norm_w, w_out, post_norm_w):
    y_prompt = _trunk(x_prompt, pre_norm_w, w_in, hgrn_lb, hgrn_norm_w, gqa_q_norm_w, gqa_k_norm_w,
                      diff_lambda, diff_norm_w, w_out, post_norm_w)
    y_sample = _trunk(x_sample, pre_norm_w, w_in, hgrn_lb, hgrn_norm_w, gqa_q_norm_w, gqa_k_norm_w,
                      diff_lambda, diff_norm_w, w_out, post_norm_w)
    return (y_prompt, y_sample)
```

```cpp
#include <hip/hip_runtime.h>
#include <hip/hip_cooperative_groups.h>
#include <cstdio>
#include <cmath>
#include <cstring>
#include <type_traits>
namespace cg = cooperative_groups;

#define DI __device__ __forceinline__
typedef unsigned short u16;
typedef unsigned int u32;
using bf16x8 = __attribute__((ext_vector_type(8))) short;
using s16x4  = __attribute__((ext_vector_type(4))) short;
using f32x16 = __attribute__((ext_vector_type(16))) float;
using f32x2  = __attribute__((ext_vector_type(2))) float;
using bf2_t  = __attribute__((ext_vector_type(2))) __bf16;
using u32x4  = __attribute__((ext_vector_type(4))) unsigned;
using u32x2  = __attribute__((ext_vector_type(2))) unsigned;
#define MFMA32(a, b, c) __builtin_amdgcn_mfma_f32_32x32x16_bf16((a), (b), (c), 0, 0, 0)

constexpr int T_TOK = 49152;
constexpr int L_PROMPT = 16384;
constexpr int DM = 1024;
constexpr int NCOL = 4352;
constexpr float EPS = 1e-6f;
constexpr float LOG2E = 1.4426950408889634f;
constexpr size_t MiB = 1u << 20;

constexpr size_t WS_HQ = 0;
constexpr size_t WS_GF = 48 * MiB;
constexpr size_t WS_GB = 96 * MiB;
constexpr size_t WS_HV = 144 * MiB;
constexpr size_t WS_Y = 0;
constexpr size_t WS_CVT = 192 * MiB;
constexpr size_t WS_XB = 216 * MiB;
constexpr size_t WS_OF = WS_XB;
constexpr size_t WS_OB = WS_XB + 48 * MiB;
constexpr size_t WS_R0 = 312 * MiB;
constexpr size_t WS_WIN = 408 * MiB;
constexpr size_t WS_WOUT = 425 * MiB;
constexpr size_t WS_TAB = 429 * MiB;
constexpr size_t WS_RSTD = 431 * MiB;
constexpr size_t WS_MISC = 431 * MiB + 256 * 1024;
constexpr size_t WS_HF = 432 * MiB;
constexpr size_t WS_HD = 456 * MiB;
constexpr int MISC_HCNT = 1200;
constexpr int MISC_BAR = 1400;
constexpr int MISC_BAR2 = 4096;
constexpr int MISC_GCTR = 1440;
constexpr size_t DO_BQ = 0;
constexpr size_t DO_CQ = 24 * MiB;
constexpr size_t DO_GA = 48 * MiB;
constexpr size_t DO_GB = 96 * MiB;
constexpr size_t DO_GC = 120 * MiB;
constexpr size_t DO_BK = 144 * MiB;
constexpr size_t DO_BVT = 156 * MiB;
constexpr size_t DO_CK = 168 * MiB;

constexpr float QS_GQA = 0.125f * LOG2E;
constexpr float QS_DIFF = 0.17677669529663687f * LOG2E;

struct Params {
  const float* x_prompt; const float* x_sample; const float* pre_norm_w; const float* w_in;
  const float* hgrn_lb; const float* hgrn_norm_w; const float* gqa_q_norm_w; const float* gqa_k_norm_w;
  const float* diff_lambda; const float* diff_norm_w; const float* w_out; const float* post_norm_w;
  char* out; char* ws;
  int dry; int wid;
};
DI int tidx(const Params& p) {
  int l = (int)__builtin_amdgcn_mbcnt_hi(~0u, __builtin_amdgcn_mbcnt_lo(~0u, 0u));
  asm volatile("" : "+v"(l));
  return p.wid * 64 + l;
}

DI u32 pack2bf(float lo, float hi) { f32x2 v = {lo, hi}; return __builtin_bit_cast(u32, __builtin_convertvector(v, bf2_t)); }
DI u16 f2bf(float x) { return (u16)(pack2bf(x, 0.f) & 0xffffu); }
DI float bf2f(u16 b) { return __uint_as_float(((u32)b) << 16); }
DI float bflo(u32 w) { return __uint_as_float(w << 16); }
DI float bfhi(u32 w) { return __uint_as_float(w & 0xffff0000u); }
DI u16 f2h(float x) { _Float16 h = (_Float16)x; return __builtin_bit_cast(u16, h); }
DI float h2f(u16 b) { return (float)__builtin_bit_cast(_Float16, b); }
DI unsigned xcc_id() { return (unsigned)__builtin_amdgcn_s_getreg((3 << 11) | 20) & 0xFu; }
DI int crow(int i, int h) { return (i & 3) + 8 * (i >> 2) + 4 * h; }
DI bf16x8 pack8(const f32x16& x, int s) {
  u32x4 p;
  p[0] = pack2bf(x[8 * s + 0], x[8 * s + 1]); p[1] = pack2bf(x[8 * s + 2], x[8 * s + 3]);
  p[2] = pack2bf(x[8 * s + 4], x[8 * s + 5]); p[3] = pack2bf(x[8 * s + 6], x[8 * s + 7]);
  return __builtin_bit_cast(bf16x8, p);
}
DI bf16x8 cat44(s16x4 lo, s16x4 hi) { return __builtin_shufflevector(lo, hi, 0, 1, 2, 3, 4, 5, 6, 7); }
DI float fadd1(float a, float b) { float r; asm("v_add_f32 %0, %1, %2" : "=v"(r) : "v"(a), "v"(b)); return r; }
DI float xhalf(float v) { return __shfl_xor(v, 32); }
DI float wave_sum(float v) { for (int o = 32; o; o >>= 1) v += __shfl_xor(v, o); return v; }
DI float wave_max(float v) { for (int o = 32; o; o >>= 1) v = fmaxf(v, __shfl_xor(v, o)); return v; }
DI float sigm(float x) { return __builtin_amdgcn_rcpf(1.f + __builtin_amdgcn_exp2f(-LOG2E * x)); }
DI int seq_of(int t) { return t < L_PROMPT ? 0 : 1 + ((t - L_PROMPT) >> 13); }
DI int pos_of(int t) { return t < L_PROMPT ? t : (t & 8191); }

DI void transpose_unit(const Params& p, int u, char* smem) {
  u16* tile = (u16*)smem;
  const int tid = tidx(p);
  const float* src; u16* dst; const float* rw = nullptr; int N, kt, nt;
  if (u < 2176) { int l = u / 1088, r = u % 1088; kt = r / 68; nt = r % 68; N = NCOL;
    src = p.w_in + (size_t)l * DM * NCOL; dst = (u16*)(p.ws + WS_WIN) + (size_t)l * NCOL * DM; rw = p.pre_norm_w + l * DM; }
  else { int v = u - 2176; int l = v / 256, r = v % 256; kt = r / 16; nt = r % 16; N = DM;
    src = p.w_out + (size_t)l * DM * DM; dst = (u16*)(p.ws + WS_WOUT) + (size_t)l * DM * DM; }
  const int c4 = (tid & 15) * 4, r0 = tid >> 4;
  __syncthreads();
#pragma unroll
  for (int i = 0; i < 4; ++i) {
    int r = r0 + 16 * i; int k = kt * 64 + r;
    float4 v = *(const float4*)(src + (size_t)k * N + nt * 64 + c4);
    float w = rw ? rw[k] : 1.f;
    tile[(c4 + 0) * 72 + r] = f2bf(v.x * w); tile[(c4 + 1) * 72 + r] = f2bf(v.y * w);
    tile[(c4 + 2) * 72 + r] = f2bf(v.z * w); tile[(c4 + 3) * 72 + r] = f2bf(v.w * w);
  }
  __syncthreads();
#pragma unroll
  for (int i = 0; i < 2; ++i) {
    int n = (tid >> 3) + 32 * i, ch = tid & 7;
    u32x4 v = *(const u32x4*)(tile + n * 72 + ch * 8);
    *(u32x4*)(dst + (size_t)(nt * 64 + n) * DM + kt * 64 + ch * 8) = v;
  }
}

DI void sincos_d(double x, float& c, float& s) {
  const double x2 = x * x;
  double ts = 0.0, tc = 0.0;
#pragma unroll
  for (int n = 14; n >= 1; --n) {
    const double cs_ = -1.0 / (double)((2 * n) * (2 * n + 1));
    const double cc_ = -1.0 / (double)((2 * n - 1) * (2 * n));
    ts = (1.0 + ts) * (x2 * cs_);
    tc = (1.0 + tc) * (x2 * cc_);
  }
  c = (float)(1.0 + tc); s = (float)(x * (1.0 + ts));
}

DI void table_unit(const Params& p, int u) {
  int idx = u * 256 + tidx(p);
  int i = idx >> 14, pos = idx & 16383;
  const int i4 = i & 3, i16 = i >> 2;
  double inv = i4 == 0 ? 1.0 : (i4 == 1 ? 0.5623413251903491 : (i4 == 2 ? 0.31622776601683794 : 0.1778279410038923));
  inv *= i16 == 0 ? 1.0 : (i16 == 1 ? 0.1 : (i16 == 2 ? 0.01 : 0.001));
  double ang = (double)pos * inv;
  double rev = ang * 0.15915494309189535;
  rev -= rint(rev);
  float c, s; sincos_d(rev * 6.283185307179586, c, s);
  ((float2*)(p.ws + WS_TAB))[idx] = make_float2(c, s);
}

DI const float* x_row(const Params& p, int row) {
  return row < L_PROMPT ? p.x_prompt + (size_t)row * DM : p.x_sample + (size_t)(row - L_PROMPT) * DM;
}

DI void rowprep(const Params& p, int mode) {
  const int wave = tidx(p) >> 6, lane = tidx(p) & 63;
  const u16* yb = (const u16*)(p.ws + WS_Y);
  u16* r0b = (u16*)(p.ws + WS_R0);
  u16* xb = (u16*)(p.ws + WS_XB);
  float* rstd = (float*)(p.ws + WS_RSTD);
  const float* pw = p.post_norm_w + (mode == 2 ? DM : 0);
  for (int row = blockIdx.x * 4 + wave; row < T_TOK; row += gridDim.x * 4) {
    const float* x0 = x_row(p, row);
    float4 xv[4];
#pragma unroll
    for (int i = 0; i < 4; ++i) xv[i] = *(const float4*)(x0 + lane * 4 + 256 * i);
    if (mode >= 1) {
      float4 yv[4]; float ss = 0.f;
#pragma unroll
      for (int i = 0; i < 4; ++i) {
        { u32x2 yp = *(const u32x2*)(yb + (size_t)row * DM + lane * 4 + 256 * i);
          yv[i] = make_float4(bflo(yp[0]), bfhi(yp[0]), bflo(yp[1]), bfhi(yp[1])); }
        ss += yv[i].x * yv[i].x + yv[i].y * yv[i].y + yv[i].z * yv[i].z + yv[i].w * yv[i].w;
      }
      ss = wave_sum(ss);
      float rs = rsqrtf(ss * (1.f / DM) + EPS);
#pragma unroll
      for (int i = 0; i < 4; ++i) {
        float4 w = *(const float4*)(pw + lane * 4 + 256 * i);
        float4 r = make_float4(yv[i].x * rs * w.x, yv[i].y * rs * w.y, yv[i].z * rs * w.z, yv[i].w * rs * w.w);
        size_t off = (size_t)row * DM + lane * 4 + 256 * i;
        if (mode == 1) {
          u16 h0 = f2h(r.x), h1 = f2h(r.y), h2 = f2h(r.z), h3 = f2h(r.w);
          u32x2 pk = {(u32)h0 | ((u32)h1 << 16), (u32)h2 | ((u32)h3 << 16)};
          *(u32x2*)(r0b + off) = pk;
          xv[i].x += h2f(h0); xv[i].y += h2f(h1); xv[i].z += h2f(h2); xv[i].w += h2f(h3);
        } else {
          u32x2 pk = *(const u32x2*)(r0b + off);
          float4 o;
          o.x = (xv[i].x + h2f((u16)(pk[0] & 0xffff))) + r.x;
          o.y = (xv[i].y + h2f((u16)(pk[0] >> 16))) + r.y;
          o.z = (xv[i].z + h2f((u16)(pk[1] & 0xffff))) + r.z;
          o.w = (xv[i].w + h2f((u16)(pk[1] >> 16))) + r.w;
          *(float4*)((float*)p.out + off) = o;
        }
      }
    }
    if (mode <= 1) {
      float ss = 0.f;
#pragma unroll
      for (int i = 0; i < 4; ++i) {
        ss += xv[i].x * xv[i].x + xv[i].y * xv[i].y + xv[i].z * xv[i].z + xv[i].w * xv[i].w;
        u32x2 pk = {pack2bf(xv[i].x, xv[i].y), pack2bf(xv[i].z, xv[i].w)};
        *(u32x2*)(xb + (size_t)row * DM + lane * 4 + 256 * i) = pk;
      }
      ss = wave_sum(ss);
      if (lane == 0) rstd[row] = rsqrtf(ss * (1.f / DM) + EPS);
    }
  }
}

DI void phase0(const Params& p, char* smem) {
  const int nb = gridDim.x, b = blockIdx.x;
  for (int u = b; u < 2688; u += nb) transpose_unit(p, u, smem);
  for (int u = b; u < 1024; u += nb) table_unit(p, u);
  rowprep(p, 0);
  if (b == 0) {
    u32* misc = (u32*)(p.ws + WS_MISC);
    float* miscf = (float*)misc;
    const int tid = tidx(p);
    if (tid < 104) misc[tid] = 0u;
    if (tid < 96) misc[MISC_HCNT + tid] = 0u;
    for (int i = tid; i < 1100; i += 256) misc[MISC_BAR2 + i] = 0u;
    if (tid < 32) misc[MISC_GCTR + tid] = 0u;
    if (tid < 2) {
      const float* lp = p.diff_lambda + tid * 128;
      float a = 0.f, c = 0.f;
      for (int i = 0; i < 32; ++i) { a += lp[i] * lp[32 + i]; c += lp[64 + i] * lp[96 + i]; }
      float lam_init = 0.8f - 0.6f * expf(-0.3f * (float)tid);
      miscf[104 + tid] = expf(a) - expf(c) + lam_init;
    }
    for (int i = tid; i < 1024; i += 256) {
      float a0 = p.hgrn_lb[i], a1 = p.hgrn_lb[1024 + i];
      miscf[128 + i] = 1.f / (1.f + expf(a0 - a1));
    }
  }
}

constexpr int HS = 136;
constexpr int VS = 40;
constexpr int H_QM = 0, H_KM = 8704, H_QB = 17408, H_KLT = 26112, H_VT = 36352, H_DEC = 46592;
constexpr int H_RAW = 47104;
constexpr int SMEM_BYTES = 47104 + 32768 + 16;
constexpr int GS = 72;
constexpr int CS = 136;

enum { K_SILU = 0, K_COPY, K_G, K_QN, K_KN, K_VT, K_CQ, K_CK };

struct TileDesc { int kind; u16* dst; int stride; int col; int aux; };

DI TileDesc tile_desc(const Params& p, int nt) {
  TileDesc d; d.aux = 0;
  char* ws = p.ws; char* o = p.out;
  if (nt < 4)       { d.kind = K_SILU; d.dst = (u16*)(ws + WS_HQ); d.stride = 512; d.col = nt * 128; }
  else if (nt < 8)  { d.kind = K_G;    d.dst = (u16*)(ws + WS_GF); d.stride = 512; d.col = (nt - 4) * 128; d.aux = 0; }
  else if (nt < 12) { d.kind = K_G;    d.dst = (u16*)(ws + WS_GB); d.stride = 512; d.col = (nt - 8) * 128; d.aux = 1; }
  else if (nt < 16) { d.kind = K_COPY; d.dst = (u16*)(ws + WS_HV); d.stride = 512; d.col = (nt - 12) * 128; }
  else if (nt < 20) { d.kind = K_SILU; d.dst = (u16*)(o + DO_GA);  d.stride = 512; d.col = (nt - 16) * 128; }
  else if (nt < 22) { d.kind = K_QN;   d.dst = (u16*)(o + DO_BQ);  d.stride = 256; d.col = (nt - 20) * 128; }
  else if (nt < 23) { d.kind = K_KN;   d.dst = (u16*)(o + DO_BK);  d.stride = 128; d.col = 0; }
  else if (nt < 24) { d.kind = K_VT;   d.dst = (u16*)(o + DO_BVT); d.stride = T_TOK; d.col = 0; }
  else if (nt < 26) { d.kind = K_SILU; d.dst = (u16*)(o + DO_GB);  d.stride = 256; d.col = (nt - 24) * 128; }
  else if (nt < 28) { d.kind = K_CQ;   d.dst = (u16*)(o + DO_CQ);  d.stride = 256; d.col = (nt - 26) * 128; }
  else if (nt < 30) { d.kind = K_CK;   d.dst = (u16*)(o + DO_CK);  d.stride = 256; d.col = (nt - 28) * 128; d.aux = (nt - 28); }
  else if (nt < 32) { d.kind = K_VT;   d.dst = (u16*)(ws + WS_CVT); d.stride = T_TOK; d.col = (nt - 30) * 128; }
  else              { d.kind = K_SILU; d.dst = (u16*)(o + DO_GC);  d.stride = 256; d.col = (nt - 32) * 128; }
  return d;
}

DI void rope_pairs(f32x16& x, const float2* tab, int pos, int h, float scale) {
#pragma unroll
  for (int i = 0; i < 8; ++i) {
    int idx = crow(i, h);
    float2 cs = tab[idx * 16384 + pos];
    float a = x[i], b = x[i + 8];
    x[i] = (a * cs.x - b * cs.y) * scale;
    x[i + 8] = (b * cs.x + a * cs.y) * scale;
  }
}

DI void rope32(float* x, const float2* tab, int pos, float scale) {
#pragma unroll
  for (int j = 0; j < 16; ++j) {
    float2 cs = tab[j * 16384 + pos];
    float a = x[j], b = x[j + 16];
    x[j] = (a * cs.x - b * cs.y) * scale;
    x[j + 16] = (b * cs.x + a * cs.y) * scale;
  }
}
DI void qk_post(const Params& p, int layer, int nt, int t0, int tid, char* smem) {
  const float2* tab = (const float2*)(p.ws + WS_TAB);
  u32* misc = (u32*)(p.ws + WS_MISC);
  const int tl = tid & 127, hh = __builtin_amdgcn_readfirstlane(tid >> 7), lane = tid & 63;
  const int pos = pos_of(t0 + tl), seq = seq_of(t0);
#pragma unroll 1
  for (int hf = 0; hf < 2; ++hf) {
    const TileDesc d = tile_desc(p, nt * 2 + hf);
    if (d.kind != K_QN && d.kind != K_KN && d.kind != K_CQ && d.kind != K_CK) continue;
    u16* row = (u16*)(smem + hf * 34816) + tl * CS + hh * 64;
    float x[64];
#pragma unroll
    for (int c = 0; c < 8; ++c) {
      u32x4 v = *(const u32x4*)(row + c * 8);
#pragma unroll
      for (int i = 0; i < 4; ++i) { x[c * 8 + 2 * i] = bflo(v[i]); x[c * 8 + 2 * i + 1] = bfhi(v[i]); }
    }
    if (d.kind == K_QN || d.kind == K_KN) {
      const float* nw = (d.kind == K_QN ? p.gqa_q_norm_w : p.gqa_k_norm_w) + layer * 64;
      float ss = 0.f;
#pragma unroll
      for (int j = 0; j < 64; ++j) ss += x[j] * x[j];
      const float rn = rsqrtf(ss * (1.f / 64.f) + EPS);
      float s2 = 0.f;
#pragma unroll
      for (int j = 0; j < 64; ++j) { x[j] *= rn * nw[j]; s2 += x[j] * x[j]; }
      const float sc = d.kind == K_QN ? QS_GQA : 1.f;
      rope32(x, tab, pos >> 6, sc);
      rope32(x + 32, tab, pos & 63, sc);
      if (d.kind == K_KN) {
        s2 = wave_max(s2);
        if (lane == 0) atomicMax(&misc[layer * 50 + seq * 10 + hh], __float_as_uint(s2 * 1.02f));
      }
    } else {
      const float sc = d.kind == K_CQ ? QS_DIFF : 1.f;
      if (d.kind == K_CK) {
#pragma unroll
        for (int m = 0; m < 2; ++m) {
          float s2 = 0.f;
#pragma unroll
          for (int j = 0; j < 32; ++j) s2 += x[m * 32 + j] * x[m * 32 + j];
          s2 = wave_max(s2);
          if (lane == 0) atomicMax(&misc[layer * 50 + seq * 10 + 2 + (d.aux * 2 + hh) * 2 + m], __float_as_uint(s2 * 1.02f));
        }
      }
      rope32(x, tab, pos, sc);
      rope32(x + 32, tab, pos, sc);
    }
#pragma unroll
    for (int c = 0; c < 8; ++c) {
      u32x4 v;
#pragma unroll
      for (int i = 0; i < 4; ++i) v[i] = pack2bf(x[c * 8 + 2 * i], x[c * 8 + 2 * i + 1]);
      *(u32x4*)(row + c * 8) = v;
    }
  }
  __syncthreads();
}

constexpr int G_STAGE = 24576;
DI int gswz(int row, int lc) { return row * 32 + ((lc ^ ((row >> 2) & 3)) << 3); }

template <bool IN_PROJ>
DI void gemm_tile(const Params& p, int layer, int nt, int tt, char* smem) {
  int tid = tidx(p);
  asm volatile("" : "+v"(tid));
  const int w = __builtin_amdgcn_readfirstlane(tid >> 6), lane = tid & 63, r = lane & 31, h = lane >> 5;
  const int wf = w >> 1, wt = w & 1;
  const int n0 = nt * 256, t0 = tt * 128;
  const u16* Wt = IN_PROJ ? (const u16*)(p.ws + WS_WIN) + (size_t)layer * NCOL * DM
                          : (const u16*)(p.ws + WS_WOUT) + (size_t)layer * DM * DM;
  const u16* xb = (const u16*)(p.ws + WS_XB);
  const u16* mixA = (const u16*)(p.ws + WS_OF);
  const u16* mixB = (const u16*)(p.out + DO_BQ);
  const u16* mixC = (const u16*)(p.out + DO_CQ);

  f32x16 acc[4][2];
#pragma unroll
  for (int a = 0; a < 4; ++a)
#pragma unroll
    for (int b = 0; b < 2; ++b)
#pragma unroll
      for (int i = 0; i < 16; ++i) acc[a][b][i] = 0.f;

  auto stage = [&](int kt) {
    const int k0 = kt * 32;
    char* base = smem + (kt % 3) * G_STAGE;
#pragma unroll
    for (int i = 0; i < 4; ++i) {
      int c = tid + 256 * i; int row = c >> 2, lc = (c & 3) ^ ((row >> 2) & 3);
      __builtin_amdgcn_global_load_lds((const unsigned*)(Wt + (size_t)(n0 + row) * DM + k0 + lc * 8), (unsigned*)(base + c * 16), 16, 0, 0);
    }
#pragma unroll
    for (int i = 0; i < 2; ++i) {
      int c = tid + 256 * i; int row = c >> 2, lc = (c & 3) ^ ((row >> 2) & 3);
      const u16* bp;
      if (IN_PROJ) bp = xb + (size_t)(t0 + row) * DM + k0 + lc * 8;
      else {
        if (k0 < 512) bp = mixA + (size_t)(t0 + row) * 512 + k0 + lc * 8;
        else if (k0 < 768) bp = mixB + (size_t)(t0 + row) * 256 + (k0 - 512) + lc * 8;
        else bp = mixC + (size_t)(t0 + row) * 256 + (k0 - 768) + lc * 8;
      }
      __builtin_amdgcn_global_load_lds((const unsigned*)bp, (unsigned*)(base + 16384 + c * 16), 16, 0, 0);
    }
  };
  asm volatile("s_waitcnt vmcnt(0)" ::: "memory");
  __syncthreads();
  stage(0); stage(1); stage(2);
  auto load_frags = [&](int kt, int ks, bf16x8 (&fa)[4], bf16x8 (&fb)[2]) {
    const u16* sA = (const u16*)(smem + (kt % 3) * G_STAGE);
    const u16* sB = sA + 8192;
#pragma unroll
    for (int fi = 0; fi < 4; ++fi) fa[fi] = *(const bf16x8*)(sA + gswz(wf * 128 + fi * 32 + r, ks * 2 + h));
#pragma unroll
    for (int ti = 0; ti < 2; ++ti) fb[ti] = *(const bf16x8*)(sB + gswz(wt * 64 + ti * 32 + r, ks * 2 + h));
  };
  auto mma = [&](const bf16x8 (&fa)[4], const bf16x8 (&fb)[2]) {
#pragma unroll
    for (int fi = 0; fi < 4; ++fi)
#pragma unroll
      for (int ti = 0; ti < 2; ++ti) acc[fi][ti] = MFMA32(fa[fi], fb[ti], acc[fi][ti]);
  };
  bf16x8 fa0[4], fb0[2], fa1[4], fb1[2];
  asm volatile("s_waitcnt vmcnt(12)" ::: "memory");
  __syncthreads();
  load_frags(0, 0, fa0, fb0);
  for (int kt = 0; kt < 32; ++kt) {
    load_frags(kt, 1, fa1, fb1);
    mma(fa0, fb0);
    if (kt + 1 < 32) {
      if (kt + 2 < 32) asm volatile("s_waitcnt vmcnt(6) lgkmcnt(0)" ::: "memory");
      else asm volatile("s_waitcnt vmcnt(0) lgkmcnt(0)" ::: "memory");
      __syncthreads();
      if (kt + 3 < 32) stage(kt + 3);
      load_frags(kt + 1, 0, fa0, fb0);
    }
    mma(fa1, fb1);
  }
  __syncthreads();

  if (!IN_PROJ) {
    u16* yb = (u16*)(p.ws + WS_Y);
    u16* sC = (u16*)(smem + wf * 34816);
#pragma unroll
    for (int fi = 0; fi < 4; ++fi)
#pragma unroll
      for (int ti = 0; ti < 2; ++ti)
#pragma unroll
        for (int g = 0; g < 4; ++g) {
          u32x2 pk = {pack2bf(acc[fi][ti][4 * g], acc[fi][ti][4 * g + 1]), pack2bf(acc[fi][ti][4 * g + 2], acc[fi][ti][4 * g + 3])};
          *(u32x2*)(sC + (wt * 64 + ti * 32 + r) * CS + fi * 32 + 8 * g + 4 * h) = pk;
        }
    __syncthreads();
#pragma unroll
    for (int hf = 0; hf < 2; ++hf) {
      const u16* sH = (const u16*)(smem + hf * 34816);
#pragma unroll
      for (int i = 0; i < 8; ++i) {
        int c = tid + 256 * i; int row = c >> 4, cc = c & 15;
        u32x4 v = *(const u32x4*)(sH + row * CS + cc * 8);
        *(u32x4*)(yb + (size_t)(t0 + row) * DM + n0 + hf * 128 + cc * 8) = v;
      }
    }
    return;
  }

  const TileDesc d = tile_desc(p, nt * 2 + wf);
  const float* rstd = (const float*)(p.ws + WS_RSTD);
  u32* misc = (u32*)(p.ws + WS_MISC);
  const float* miscf = (const float*)misc;
  u16* sC = (u16*)(smem + wf * 34816);
#pragma unroll
  for (int ti = 0; ti < 2; ++ti) {
    const int t = t0 + wt * 64 + ti * 32 + r;
    const float rs = rstd[t];
#pragma unroll
    for (int fi = 0; fi < 4; ++fi)
#pragma unroll
      for (int i = 0; i < 16; ++i) acc[fi][ti][i] *= rs;
    if (d.kind == K_SILU) {
#pragma unroll
      for (int fi = 0; fi < 4; ++fi)
#pragma unroll
        for (int i = 0; i < 16; ++i) { float x = acc[fi][ti][i]; acc[fi][ti][i] = x * sigm(x); }
    } else if (d.kind == K_G) {
#pragma unroll
      for (int fi = 0; fi < 4; ++fi)
#pragma unroll
        for (int g = 0; g < 4; ++g) {
          float4 lb4 = make_float4(0.f, 0.f, 0.f, 0.f);
          if (layer != 0) lb4 = *(const float4*)(miscf + 128 + d.aux * 512 + d.col + fi * 32 + 8 * g + 4 * h);
          acc[fi][ti][4 * g] = __logf(lb4.x + (1.f - lb4.x) * sigm(acc[fi][ti][4 * g]));
          acc[fi][ti][4 * g + 1] = __logf(lb4.y + (1.f - lb4.y) * sigm(acc[fi][ti][4 * g + 1]));
          acc[fi][ti][4 * g + 2] = __logf(lb4.z + (1.f - lb4.z) * sigm(acc[fi][ti][4 * g + 2]));
          acc[fi][ti][4 * g + 3] = __logf(lb4.w + (1.f - lb4.w) * sigm(acc[fi][ti][4 * g + 3]));
        }
    }
    if (d.kind == K_VT) {
      const int rp = (r & ~12) | ((r & 4) << 1) | ((r & 8) >> 1);
#pragma unroll
      for (int fi = 0; fi < 4; ++fi)
#pragma unroll
        for (int i = 0; i < 16; ++i)
          sC[(fi * 32 + crow(i, h)) * CS + wt * 64 + ti * 32 + rp] = f2bf(acc[fi][ti][i]);
    } else {
#pragma unroll
      for (int fi = 0; fi < 4; ++fi)
#pragma unroll
        for (int g = 0; g < 4; ++g) {
          u32x2 pk;
          if (d.kind == K_G) {
            pk[0] = (u32)f2h(acc[fi][ti][4 * g]) | ((u32)f2h(acc[fi][ti][4 * g + 1]) << 16);
            pk[1] = (u32)f2h(acc[fi][ti][4 * g + 2]) | ((u32)f2h(acc[fi][ti][4 * g + 3]) << 16);
          } else {
            pk[0] = pack2bf(acc[fi][ti][4 * g], acc[fi][ti][4 * g + 1]);
            pk[1] = pack2bf(acc[fi][ti][4 * g + 2], acc[fi][ti][4 * g + 3]);
          }
          *(u32x2*)(sC + (wt * 64 + ti * 32 + r) * CS + fi * 32 + 8 * g + 4 * h) = pk;
        }
    }
  }
  __syncthreads();
  if (nt == 10 || nt == 11 || nt == 13 || nt == 14) qk_post(p, layer, nt, t0, tid, smem);
#pragma unroll
  for (int hf = 0; hf < 2; ++hf) {
    const TileDesc dd = tile_desc(p, nt * 2 + hf);
    const u16* sH = (const u16*)(smem + hf * 34816);
#pragma unroll
    for (int i = 0; i < 8; ++i) {
      int c = tid + 256 * i; int row = c >> 4, cc = c & 15;
      u32x4 v = *(const u32x4*)(sH + row * CS + cc * 8);
      if (dd.kind == K_VT) *(u32x4*)(dd.dst + (size_t)(dd.col + row) * T_TOK + t0 + cc * 8) = v;
      else *(u32x4*)(dd.dst + (size_t)(t0 + row) * dd.stride + dd.col + cc * 8) = v;
    }
  }
}

template <bool IN_PROJ>
DI void gemm_phase(const Params& p, int layer, char* smem) {
  constexpr int NT = IN_PROJ ? 17 : 4;
  constexpr int PER_XCD = 48 * NT;
  u32* ctr = (u32*)(p.ws + WS_MISC) + MISC_GCTR + layer * 16 + (IN_PROJ ? 0 : 8);
  int* s_tile = (int*)(smem + SMEM_BYTES - 16);
  const int x0 = (int)xcc_id() & 7;
  for (int a = 0; a < 8; ++a) {
    const int xq = (x0 + a) & 7;
    for (;;) {
      __syncthreads();
      if (tidx(p) == 0) *s_tile = (int)atomicAdd(ctr + xq, 1u);
      __syncthreads();
      const int q = __builtin_amdgcn_readfirstlane(*s_tile);
      if (q >= PER_XCD) break;
      int grp = q / (8 * NT), rem = q % (8 * NT);
      int nt = rem >> 3; int ttl = grp * 8 + (rem & 7);
      int tt = ttl * 8 + xq;
      gemm_tile<IN_PROJ>(p, layer, nt, tt, smem);
    }
  }
}


constexpr int HSEG = 128;
constexpr int H_UNITS = 96;

template <int PASS>
DI void hgrn_unit(const Params& p, int layer, int unit, char* smem) {
  int seq, grp, seg, nseg, ubase;
  if (unit < 32) { seq = 0; grp = unit >> 2; seg = unit & 3; nseg = 4; ubase = unit & ~3; }
  else { int u = unit - 32; seq = 1 + (u >> 4); grp = (u & 15) >> 1; seg = u & 1; nseg = 2; ubase = unit & ~1; }
  const int hd = grp >> 1, dir = grp & 1;
  const int seq_start = seq == 0 ? 0 : L_PROMPT + (seq - 1) * 8192;
  const int nch = nseg * HSEG;
  int tid = tidx(p);
  asm volatile("" : "+v"(tid));
  const int w = __builtin_amdgcn_readfirstlane(tid >> 6), lane = tid & 63, r = lane & 31, h = lane >> 5;
  const int d = tid & 127, half = tid >> 7;
  const u16* gq = (const u16*)(p.ws + WS_HQ) + hd * 128;
  const u16* gg = (const u16*)(p.ws + (dir ? WS_GB : WS_GF)) + hd * 128;
  const u16* gv = (const u16*)(p.ws + WS_HV) + hd * 128;
  u16* od = (u16*)(p.ws + (dir ? WS_OB : WS_OF));
  u16* sQm = (u16*)(smem + H_QM); u16* sKm = (u16*)(smem + H_KM); u16* sQb = (u16*)(smem + H_QB);
  u16* sKlT = (u16*)(smem + H_KLT); u16* sVt = (u16*)(smem + H_VT);
  float* sDec = (float*)(smem + H_DEC);
  float* HF = (float*)(p.ws + WS_HF); float* HD = (float*)(p.ws + WS_HD);
  u32* cnt = (u32*)(p.ws + WS_MISC) + MISC_HCNT + layer * 40 + seq * 8 + grp;

  f32x16 S[4];
#pragma unroll
  for (int b = 0; b < 4; ++b)
#pragma unroll
    for (int i = 0; i < 16; ++i) S[b][i] = 0.f;

  auto chunk_t0 = [&](int c) { return seq_start + (dir ? (nch - 1 - c) : c) * 32; };
  char* rawW = smem + H_RAW + w * 8192;
  const int dcol = (w & 1) * 64;
  auto gl = [&](int c) {
    const int t0 = chunk_t0(c);
    const int row8 = lane >> 3, ch = lane & 7;
#pragma unroll
    for (int i = 0; i < 4; ++i) {
      int j = 8 * i + row8;
      size_t off = (size_t)(dir ? t0 + 31 - j : t0 + j) * 512 + dcol + ch * 8;
      __builtin_amdgcn_global_load_lds((const unsigned*)(gg + off), (unsigned*)(rawW + i * 1024 + lane * 16), 16, 0, 0);
    }
#pragma unroll
    for (int i = 0; i < 2; ++i) {
      int j = half * 16 + 8 * i + row8;
      size_t off = (size_t)(dir ? t0 + 31 - j : t0 + j) * 512 + dcol + ch * 8;
      if (PASS == 2) __builtin_amdgcn_global_load_lds((const unsigned*)(gq + off), (unsigned*)(rawW + 4096 + i * 1024 + lane * 16), 16, 0, 0);
      __builtin_amdgcn_global_load_lds((const unsigned*)(gv + off), (unsigned*)(rawW + 6144 + i * 1024 + lane * 16), 16, 0, 0);
    }
  };
  const int c_begin = seg * HSEG, c_end = c_begin + HSEG;
  __syncthreads();
  gl(c_begin);
  if (PASS == 2 && seg > 0) {
    if (tid == 0) { while (__hip_atomic_load(cnt, __ATOMIC_RELAXED, __HIP_MEMORY_SCOPE_AGENT) < (u32)nseg) __builtin_amdgcn_s_sleep(8); }
    __syncthreads();
    __threadfence();
    for (int j = 0; j < seg; ++j) {
      const float* Fj = HF + ((size_t)(ubase + j) * 256 + tid) * 64;
      const float* Dj = HD + (size_t)(ubase + j) * 128;
#pragma unroll
      for (int db = 0; db < 4; ++db)
#pragma unroll
        for (int g = 0; g < 4; ++g) {
          float4 dc = *(const float4*)(Dj + db * 32 + 8 * g + 4 * h);
          float4 f = *(const float4*)(Fj + db * 16 + 4 * g);
          S[db][4 * g] = S[db][4 * g] * dc.x + f.x; S[db][4 * g + 1] = S[db][4 * g + 1] * dc.y + f.y;
          S[db][4 * g + 2] = S[db][4 * g + 2] * dc.z + f.z; S[db][4 * g + 3] = S[db][4 * g + 3] * dc.w + f.w;
        }
    }
  }
  float logD = 0.f;
  for (int c = c_begin; c < c_end; ++c) {
    const int t0 = chunk_t0(c);
    asm volatile("s_waitcnt vmcnt(0)" ::: "memory");
    const u16* rG = (const u16*)rawW; const u16* rQ = rG + 2048; const u16* rV = rG + 3072;
    float tot0 = 0.f, tot1 = 0.f, g16;
    float gval[16]; u16 qraw[16], vraw[16];
#pragma unroll
    for (int j = 0; j < 32; ++j) {
      float g = h2f(rG[j * 64 + lane]);
      if (j < 16) tot0 += g; else tot1 += g;
      if (j == 16) g16 = g;
      if ((j >> 4) == half) gval[j & 15] = g;
    }
#pragma unroll
    for (int jj = 0; jj < 16; ++jj) { if (PASS == 2) qraw[jj] = rQ[jj * 64 + lane]; vraw[jj] = rV[jj * 64 + lane]; }
    asm volatile("s_waitcnt lgkmcnt(0)" ::: "memory");
    __builtin_amdgcn_sched_barrier(0);
    if (c + 1 < c_end) gl(c + 1);
    __syncthreads();
    const float bmid = tot0 + g16, blast = tot0 + tot1;
    logD += blast;
    float run = half ? tot0 : 0.f;
    u32 klp[8], vtp[8];
    if (PASS == 2) {
      const float Emid = __expf(bmid), Elm = __expf(blast - bmid);
#pragma unroll
      for (int jj = 0; jj < 16; jj += 2) {
        float kl2[2];
#pragma unroll
        for (int u = 0; u < 2; ++u) {
          const int j = half * 16 + jj + u;
          run += gval[jj + u];
          float e1 = __expf(run - bmid), e2 = __expf(bmid - run);
          float q = bf2f(qraw[jj + u]);
          float k = 1.f - __expf(gval[jj + u]);
          float qm = q * e1, km = k * e2;
          kl2[u] = km * Elm;
          sQm[j * HS + d] = f2bf(qm); sKm[j * HS + d] = f2bf(km); sQb[j * HS + d] = f2bf(qm * Emid);
        }
        klp[jj >> 1] = pack2bf(kl2[0], kl2[1]);
      }
    } else {
#pragma unroll
      for (int jj = 0; jj < 16; jj += 2) {
        float kl2[2];
#pragma unroll
        for (int u = 0; u < 2; ++u) {
          run += gval[jj + u];
          kl2[u] = (1.f - __expf(gval[jj + u])) * __expf(blast - run);
        }
        klp[jj >> 1] = pack2bf(kl2[0], kl2[1]);
      }
    }
#pragma unroll
    for (int jj = 0; jj < 16; jj += 2)
      vtp[jj >> 1] = (u32)vraw[jj] | ((u32)vraw[jj + 1] << 16);
    {
      u32x4 a = {klp[0], klp[1], klp[2], klp[3]}, b = {klp[4], klp[5], klp[6], klp[7]};
      *(u32x4*)(sKlT + d * VS + half * 16) = a; *(u32x4*)(sKlT + d * VS + half * 16 + 8) = b;
      u32x4 c0 = {vtp[0], vtp[1], vtp[2], vtp[3]}, c1 = {vtp[4], vtp[5], vtp[6], vtp[7]};
      *(u32x4*)(sVt + d * VS + half * 16) = c0; *(u32x4*)(sVt + d * VS + half * 16 + 8) = c1;
    }
    if (half) sDec[d] = __expf(blast);
    __syncthreads();
    if (PASS == 2) {
      f32x16 at, oT;
#pragma unroll
      for (int i = 0; i < 16; ++i) { at[i] = 0.f; oT[i] = 0.f; }
#pragma unroll
      for (int ks = 0; ks < 8; ++ks) {
        bf16x8 a = *(const bf16x8*)(sKm + r * HS + ks * 16 + 8 * h);
        bf16x8 b = *(const bf16x8*)(sQm + r * HS + ks * 16 + 8 * h);
        at = MFMA32(a, b, at);
      }
#pragma unroll
      for (int i = 0; i < 16; ++i) if (crow(i, h) > r) at[i] = 0.f;
#pragma unroll
      for (int db = 0; db < 4; ++db)
#pragma unroll
        for (int s2 = 0; s2 < 2; ++s2) {
          bf16x8 a = pack8(S[db], s2);
          s16x4 lo = *(const s16x4*)(sQb + r * HS + db * 32 + s2 * 16 + 4 * h);
          s16x4 hi = *(const s16x4*)(sQb + r * HS + db * 32 + s2 * 16 + 8 + 4 * h);
          oT = MFMA32(a, cat44(lo, hi), oT);
        }
#pragma unroll
      for (int ks = 0; ks < 2; ++ks) {
        s16x4 lo = *(const s16x4*)(sVt + (32 * w + r) * VS + 16 * ks + 4 * h);
        s16x4 hi = *(const s16x4*)(sVt + (32 * w + r) * VS + 16 * ks + 8 + 4 * h);
        oT = MFMA32(cat44(lo, hi), pack8(at, ks), oT);
      }
      int tok = dir ? t0 + 31 - r : t0 + r;
#pragma unroll
      for (int g = 0; g < 4; ++g) {
        u32x2 pk = {pack2bf(oT[4 * g], oT[4 * g + 1]), pack2bf(oT[4 * g + 2], oT[4 * g + 3])};
        *(u32x2*)(od + (size_t)tok * 512 + hd * 128 + 32 * w + 8 * g + 4 * h) = pk;
      }
    }
    if (PASS == 1 || c + 1 < c_end) {
#pragma unroll
      for (int db = 0; db < 4; ++db) {
#pragma unroll
        for (int g = 0; g < 4; ++g) {
          float4 dc = *(const float4*)(sDec + db * 32 + 8 * g + 4 * h);
          S[db][4 * g] *= dc.x; S[db][4 * g + 1] *= dc.y; S[db][4 * g + 2] *= dc.z; S[db][4 * g + 3] *= dc.w;
        }
#pragma unroll
        for (int ks = 0; ks < 2; ++ks) {
          bf16x8 a = *(const bf16x8*)(sKlT + (db * 32 + r) * VS + 16 * ks + 8 * h);
          bf16x8 b = *(const bf16x8*)(sVt + (32 * w + r) * VS + 16 * ks + 8 * h);
          S[db] = MFMA32(a, b, S[db]);
        }
      }
    }
  }
  if (PASS == 1) {
    float* Fu = HF + ((size_t)unit * 256 + tid) * 64;
#pragma unroll
    for (int db = 0; db < 4; ++db)
#pragma unroll
      for (int g = 0; g < 4; ++g)
        *(float4*)(Fu + db * 16 + 4 * g) = make_float4(S[db][4 * g], S[db][4 * g + 1], S[db][4 * g + 2], S[db][4 * g + 3]);
    if (half == 0) HD[(size_t)unit * 128 + d] = __expf(logD);
    __threadfence();
    __syncthreads();
    if (tid == 0) atomicAdd(cnt, 1u);
  }
}

DI void hgrn_finalize(const Params& p, int layer) {
  const int wave = tidx(p) >> 6, lane = tidx(p) & 63;
  u16* of = (u16*)(p.ws + WS_OF); const u16* ob = (const u16*)(p.ws + WS_OB);
  const u16* ga = (const u16*)(p.out + DO_GA);
  const float* nw = p.hgrn_norm_w + layer * 512 + lane * 8;
  float wv[8];
#pragma unroll
  for (int i = 0; i < 8; ++i) wv[i] = nw[i];
  for (int t = blockIdx.x * 4 + wave; t < T_TOK; t += gridDim.x * 4) {
    size_t off = (size_t)t * 512 + lane * 8;
    u32x4 a = *(const u32x4*)(of + off), b = *(const u32x4*)(ob + off), g = *(const u32x4*)(ga + off);
    float v[8]; float ss = 0.f;
#pragma unroll
    for (int i = 0; i < 4; ++i) {
      v[2 * i] = bflo(a[i]) + bflo(b[i]); v[2 * i + 1] = bfhi(a[i]) + bfhi(b[i]);
      ss += v[2 * i] * v[2 * i] + v[2 * i + 1] * v[2 * i + 1];
    }
    ss += __shfl_xor(ss, 1); ss += __shfl_xor(ss, 2); ss += __shfl_xor(ss, 4); ss += __shfl_xor(ss, 8);
    float rn = rsqrtf(ss * (1.f / 128.f) + EPS);
    u32x4 o;
#pragma unroll
    for (int i = 0; i < 4; ++i)
      o[i] = pack2bf(v[2 * i] * rn * wv[2 * i] * bflo(g[i]), v[2 * i + 1] * rn * wv[2 * i + 1] * bfhi(g[i]));
    *(u32x4*)(of + off) = o;
  }
}

DI int swz(int row, int lc) { return row * 64 + ((lc ^ ((row >> 1) & 7)) << 3); }

template <int NKS>
DI void attn_tile(const Params& p, int layer, int seq, int slot, int qt, char* smem, bool wr = true) {
  int tid = tidx(p);
  asm volatile("" : "+v"(tid));
  const int w = __builtin_amdgcn_readfirstlane(tid >> 6), lane = tid & 63, r = lane & 31, h = lane >> 5;
  const int sub = w >> 1, qhalf = w & 1;
  const int seq_start = seq == 0 ? 0 : L_PROMPT + (seq - 1) * 8192;
  const int L = seq == 0 ? L_PROMPT : 8192;
  const int q0 = seq_start + qt * 128 + qhalf * 64;
  const u32* misc = (const u32*)(p.ws + WS_MISC);
  const float* miscf = (const float*)misc;
  constexpr bool GQA = (NKS == 4);
  const int hd = GQA ? (2 * slot + sub) : (slot - 2);
  u16* Qb; const u16* Kb; const u16* VT; int kstride, ks0, kslot;
  if (GQA) { Qb = (u16*)(p.out + DO_BQ) + hd * 64; Kb = (const u16*)(p.out + DO_BK) + slot * 64; kstride = 128;
             VT = (const u16*)(p.out + DO_BVT) + (size_t)(slot * 64) * T_TOK; ks0 = 0; kslot = slot; }
  else { Qb = (u16*)(p.out + DO_CQ) + hd * 64 + 32 * sub; Kb = (const u16*)(p.out + DO_CK) + hd * 64; kstride = 256;
         VT = (const u16*)(p.ws + WS_CVT) + (size_t)(hd * 64) * T_TOK; ks0 = 2 * sub; kslot = 2 + hd * 2 + sub; }
  const float kmax = sqrtf(__uint_as_float(misc[layer * 50 + seq * 10 + kslot]));

  bf16x8 qf[2][NKS]; float ncb[2], lsum[2];
  f32x16 O[2][2];
#pragma unroll
  for (int qb = 0; qb < 2; ++qb) {
    float ss = 0.f;
#pragma unroll
    for (int ks = 0; ks < NKS; ++ks) {
      u32x4 v = *(const u32x4*)(Qb + (size_t)(q0 + 32 * qb + r) * 256 + 16 * ks + 8 * h);
      qf[qb][ks] = __builtin_bit_cast(bf16x8, v);
#pragma unroll
      for (int i = 0; i < 4; ++i) { float a = bflo(v[i]), b = bfhi(v[i]); ss += a * a + b * b; }
    }
    ss += xhalf(ss);
    ncb[qb] = -sqrtf(ss) * kmax; lsum[qb] = 0.f;
#pragma unroll
    for (int eb = 0; eb < 2; ++eb)
#pragma unroll
      for (int i = 0; i < 16; ++i) O[qb][eb][i] = 0.f;
  }

  auto stage = [&](int kt) {
    const int k0 = seq_start + kt * 128;
    char* base = smem + (kt & 1) * 32768;
#pragma unroll 1
    for (int i = 0; i < 4; ++i) {
      int c = tid + 256 * i; int row = c >> 3, lc = (c & 7) ^ ((row >> 1) & 7);
      __builtin_amdgcn_global_load_lds((const unsigned*)(Kb + (size_t)(k0 + row) * kstride + lc * 8), (unsigned*)(base + c * 16), 16, 0, 0);
      int sub = c >> 9, er = (c & 511) >> 3;
      __builtin_amdgcn_global_load_lds((const unsigned*)(VT + (size_t)er * T_TOK + k0 + sub * 64 + lc * 8), (unsigned*)(base + 16384 + c * 16), 16, 0, 0);
    }
  };
  const int nkt = L >> 7;
  const bool fast = wave_max(fmaxf(-ncb[0], -ncb[1])) < 60.f;
  auto mainloop = [&](auto SUBT) {
    constexpr bool SUB = decltype(SUBT)::value;
    for (int kt = 0; kt < nkt; ++kt) {
      asm volatile("s_waitcnt vmcnt(0)" ::: "memory");
      __syncthreads();
      if (kt + 1 < nkt) stage(kt + 1);
#pragma unroll 1
      for (int kh = 0; kh < 2; ++kh) {
      const u16* sK = (const u16*)(smem + (kt & 1) * 32768 + kh * 8192);
      const u16* sV = (const u16*)(smem + (kt & 1) * 32768 + 16384 + kh * 8192);
      auto kb_body = [&](int kb) {
        bf16x8 kf[NKS];
#pragma unroll
        for (int ks = 0; ks < NKS; ++ks) kf[ks] = *(const bf16x8*)(sK + swz(32 * kb + r, 2 * (ks0 + ks) + h));
        bf16x8 pk[2][2];
#pragma unroll
        for (int qb = 0; qb < 2; ++qb) {
          f32x16 st;
#pragma unroll
          for (int i = 0; i < 16; ++i) st[i] = SUB ? ncb[qb] : 0.f;
#pragma unroll
          for (int ks = 0; ks < NKS; ++ks) st = MFMA32(kf[ks], qf[qb][ks], st);
          float ls = 0.f;
#pragma unroll
          for (int i = 0; i < 16; ++i) { float e = __builtin_amdgcn_exp2f(st[i]); st[i] = e; ls = fadd1(ls, e); }
          lsum[qb] += ls;
          pk[qb][0] = pack8(st, 0); pk[qb][1] = pack8(st, 1);
        }
#pragma unroll
        for (int eb = 0; eb < 2; ++eb)
#pragma unroll
          for (int s2 = 0; s2 < 2; ++s2) {
            bf16x8 vf = *(const bf16x8*)(sV + swz(32 * eb + r, 4 * kb + 2 * s2 + h));
#pragma unroll
            for (int qb = 0; qb < 2; ++qb) O[qb][eb] = MFMA32(vf, pk[qb][s2], O[qb][eb]);
          }
      };
      if constexpr (SUB) {
#pragma unroll 1
        for (int kb = 0; kb < 2; ++kb) kb_body(kb);
      } else {
        kb_body(0); kb_body(1);
      }
      }
    }
  };
  __syncthreads();
  stage(0);
  if (fast) mainloop(std::false_type{}); else mainloop(std::true_type{});
  __syncthreads();
  if (GQA) {
    const u16* gate = (const u16*)(p.out + DO_GB) + hd * 64;
#pragma unroll
    for (int qb = 0; qb < 2; ++qb) {
      const float inv = 1.f / (lsum[qb] + xhalf(lsum[qb]));
      const size_t t = (size_t)(q0 + 32 * qb + r);
#pragma unroll
      for (int eb = 0; eb < 2; ++eb)
#pragma unroll
        for (int g = 0; g < 4; ++g) {
          int e = 32 * eb + 8 * g + 4 * h;
          u32x2 gt = *(const u32x2*)(gate + t * 256 + e);
          u32x2 o = {pack2bf(O[qb][eb][4 * g] * inv * bflo(gt[0]), O[qb][eb][4 * g + 1] * inv * bfhi(gt[0])),
                     pack2bf(O[qb][eb][4 * g + 2] * inv * bflo(gt[1]), O[qb][eb][4 * g + 3] * inv * bfhi(gt[1]))};
          if (wr) *(u32x2*)(Qb + t * 256 + e) = o;
        }
    }
  } else {
    float* xch = (float*)smem;
    const float lam = miscf[104 + layer];
    const float post = 1.f - (0.8f - 0.6f * __expf(-0.3f * (float)layer));
    const u16* gate = (const u16*)(p.out + DO_GC) + hd * 64;
    u16* outb = (u16*)(p.out + DO_CQ) + hd * 64;
    const float* dnw = p.diff_norm_w + layer * 64;
#pragma unroll
    for (int qb = 0; qb < 2; ++qb) {
      const float inv = 1.f / (lsum[qb] + xhalf(lsum[qb]));
      if (sub == 1) {
#pragma unroll
        for (int eb = 0; eb < 2; ++eb)
#pragma unroll
          for (int i = 0; i < 16; ++i) xch[(qhalf * 32 + eb * 16 + i) * 64 + lane] = O[qb][eb][i] * inv;
      }
      __syncthreads();
      if (sub == 0) {
        float ss = 0.f;
#pragma unroll
        for (int eb = 0; eb < 2; ++eb)
#pragma unroll
          for (int i = 0; i < 16; ++i) {
            float v = O[qb][eb][i] * inv - lam * xch[(qhalf * 32 + eb * 16 + i) * 64 + lane];
            O[qb][eb][i] = v; ss += v * v;
          }
        ss += xhalf(ss);
        const float rn = rsqrtf(ss * (1.f / 64.f) + EPS) * post;
        const size_t t = (size_t)(q0 + 32 * qb + r);
#pragma unroll
        for (int eb = 0; eb < 2; ++eb)
#pragma unroll
          for (int g = 0; g < 4; ++g) {
            int e = 32 * eb + 8 * g + 4 * h;
            u32x2 gt = *(const u32x2*)(gate + t * 256 + e);
            float4 nw = *(const float4*)(dnw + e);
            u32x2 o = {pack2bf(O[qb][eb][4 * g] * rn * nw.x * bflo(gt[0]), O[qb][eb][4 * g + 1] * rn * nw.y * bfhi(gt[0])),
                       pack2bf(O[qb][eb][4 * g + 2] * rn * nw.z * bflo(gt[1]), O[qb][eb][4 * g + 3] * rn * nw.w * bfhi(gt[1]))};
            if (wr) *(u32x2*)(outb + t * 256 + e) = o;
          }
      }
      __syncthreads();
    }
  }
}

template <int NKS>
DI void attn_loop(const Params& p, int layer, char* smem, bool wr = true) {
  constexpr int NSLOT = NKS == 4 ? 2 : 4, SLOT0 = NKS == 4 ? 0 : 2;
  u32* ctr = (u32*)(p.ws + WS_MISC) + (wr ? 100 : MISC_HCNT + 90) + layer * 2 + (NKS == 4 ? 0 : 1);
  int* s_tile = (int*)(smem + SMEM_BYTES - 16);
  for (;;) {
    __syncthreads();
    if (tidx(p) == 0) *s_tile = (int)atomicAdd(ctr, 1u);
    __syncthreads();
    const int idx = __builtin_amdgcn_readfirstlane(*s_tile);
    if (idx >= NSLOT * 384) break;
    int seq, slot, qt;
    if (idx < NSLOT * 128) { seq = 0; slot = idx >> 7; qt = idx & 127; }
    else { int i2 = idx - NSLOT * 128; seq = 1 + i2 / (NSLOT * 64); int rem = i2 % (NSLOT * 64); slot = rem >> 6; qt = rem & 63; }
    attn_tile<NKS>(p, layer, seq, SLOT0 + slot, qt, smem, wr);
  }
}

DI void mixer_phase(const Params& p, int layer, char* smem) {
  for (int u = blockIdx.x; u < H_UNITS; u += gridDim.x) hgrn_unit<1>(p, layer, u, smem);
  for (int u = blockIdx.x; u < H_UNITS; u += gridDim.x) hgrn_unit<2>(p, layer, u, smem);
#ifdef PROBE_DUP_ATTN
  if (p.dry) { attn_loop<2>(p, layer, smem, false); attn_loop<4>(p, layer, smem, false); }
#endif
  attn_loop<4>(p, layer, smem);
  attn_loop<2>(p, layer, smem);
}

template <int PH>
DI void run_phase(const Params& p, char* smem) {
  if (PH == 0) { phase0(p, smem); return; }
  constexpr int layer = (PH - 1) / 5, s = (PH - 1) % 5;
  if (s == 0) { gemm_phase<true>(p, layer, smem);
#ifdef PROBE_DUP_GIN
    __syncthreads(); gemm_phase<true>(p, layer, smem);
#endif
  }
  else if (s == 1) mixer_phase(p, layer, smem);
  else if (s == 2) hgrn_finalize(p, layer);
  else if (s == 3) { gemm_phase<false>(p, layer, smem);
#ifdef PROBE_DUP_GOUT
    __syncthreads(); gemm_phase<false>(p, layer, smem);
#endif
  }
  else rowprep(p, layer == 0 ? 1 : 2);
}

DI void grid_barrier(const Params& p, unsigned k) {
  __syncthreads();
  if (tidx(p) == 0) {
    u32* bar = (u32*)(p.ws + WS_MISC) + MISC_BAR2;
    const unsigned g = blockIdx.x & 7u, gsize = gridDim.x >> 3;
    __threadfence();
    const unsigned t = __hip_atomic_fetch_add(bar + g * 64, 1u, __ATOMIC_RELAXED, __HIP_MEMORY_SCOPE_AGENT);
    if (t + 1 == k * gsize) {
      __hip_atomic_fetch_add(bar + 1024, 1u, __ATOMIC_RELAXED, __HIP_MEMORY_SCOPE_AGENT);
      while (__hip_atomic_load(bar + 1024, __ATOMIC_RELAXED, __HIP_MEMORY_SCOPE_AGENT) < 8u * k) __builtin_amdgcn_s_sleep(2);
      __hip_atomic_store(bar + 512 + g * 64, k, __ATOMIC_RELAXED, __HIP_MEMORY_SCOPE_AGENT);
    } else {
      while (__hip_atomic_load(bar + 512 + g * 64, __ATOMIC_RELAXED, __HIP_MEMORY_SCOPE_AGENT) < k) __builtin_amdgcn_s_sleep(2);
    }
    __threadfence();
  }
  __syncthreads();
}

#ifndef MULTI_LAUNCH
__global__ void __launch_bounds__(256, 2) hymba_mega(Params p0) {
  __shared__ __attribute__((aligned(16))) char smem[SMEM_BYTES];
  Params p = p0;
  p.wid = __builtin_amdgcn_readfirstlane(threadIdx.x >> 6);
  const unsigned nb = gridDim.x;
  run_phase<0>(p, smem); cg::this_grid().sync();
  run_phase<1>(p, smem); grid_barrier(p, 1);
  run_phase<2>(p, smem); grid_barrier(p, 2);
  run_phase<3>(p, smem); grid_barrier(p, 3);
  run_phase<4>(p, smem); grid_barrier(p, 4);
  run_phase<5>(p, smem); grid_barrier(p, 5);
  run_phase<6>(p, smem); grid_barrier(p, 6);
  run_phase<7>(p, smem); grid_barrier(p, 7);
  run_phase<8>(p, smem); grid_barrier(p, 8);
  run_phase<9>(p, smem); grid_barrier(p, 9);
  run_phase<10>(p, smem);
}
#else
template <int PH>
__global__ void __launch_bounds__(256, 2) hymba_phase(Params p0) {
  __shared__ __attribute__((aligned(16))) char smem[SMEM_BYTES];
  Params p = p0;
  p.wid = __builtin_amdgcn_readfirstlane(threadIdx.x >> 6);
  run_phase<PH>(p, smem);
}
#endif

extern "C" void kernel_launch(void* const* d_in, const int* in_sizes, int n_in, void* d_out, int out_size,
                              void* d_ws, size_t ws_size, hipStream_t stream) {
  static int grid_blocks = 0;
  if (!grid_blocks) {
    int dev = 0, cus = 0, per_cu = 2;
    (void)hipGetDevice(&dev);
    (void)hipDeviceGetAttribute(&cus, hipDeviceAttributeMultiprocessorCount, dev);
#ifndef MULTI_LAUNCH
    (void)hipOccupancyMaxActiveBlocksPerMultiprocessor(&per_cu, hymba_mega, 256, 0);
#endif
    if (per_cu > 2) per_cu = 2;
    if (per_cu < 1) per_cu = 1;
    grid_blocks = cus * per_cu;
  }
  Params p;
  memset(&p, 0, sizeof(p));
  p.x_prompt = (const float*)d_in[0]; p.x_sample = (const float*)d_in[1]; p.pre_norm_w = (const float*)d_in[2];
  p.w_in = (const float*)d_in[3]; p.hgrn_lb = (const float*)d_in[4]; p.hgrn_norm_w = (const float*)d_in[5];
  p.gqa_q_norm_w = (const float*)d_in[6]; p.gqa_k_norm_w = (const float*)d_in[7]; p.diff_lambda = (const float*)d_in[8];
  p.diff_norm_w = (const float*)d_in[9]; p.w_out = (const float*)d_in[10]; p.post_norm_w = (const float*)d_in[11];
  p.out = (char*)d_out; p.ws = (char*)d_ws;
#ifdef PROBE_DUP_ATTN
  p.dry = 1;
#endif
#ifndef MULTI_LAUNCH
  void* args[] = {&p};
  hipError_t e = hipLaunchCooperativeKernel((void*)hymba_mega, dim3(grid_blocks), dim3(256), args, 0, stream);
  if (e != hipSuccess) fprintf(stderr, "cooperative launch failed: %s (grid %d)\n", hipGetErrorString(e), grid_blocks);
#else
  dim3 g(grid_blocks), b(256);
  hymba_phase<0><<<g, b, 0, stream>>>(p); hymba_phase<1><<<g, b, 0, stream>>>(p); hymba_phase<2><<<g, b, 0, stream>>>(p);
  hymba_phase<3><<<g, b, 0, stream>>>(p); hymba_phase<4><<<g, b, 0, stream>>>(p); hymba_phase<5><<<g, b, 0, stream>>>(p);
  hymba_phase<6><<<g, b, 0, stream>>>(p); hymba_phase<7><<<g, b, 0, stream>>>(p); hymba_phase<8><<<g, b, 0, stream>>>(p);
  hymba_phase<9><<<g, b, 0, stream>>>(p); hymba_phase<10><<<g, b, 0, stream>>>(p);
#endif
}
```

```cpp
#include <hip/hip_runtime.h>
#include <hip/hip_cooperative_groups.h>
#include <cstdio>
#include <cmath>
#include <cstring>
#include <type_traits>
namespace cg = cooperative_groups;

#define DI __device__ __forceinline__
typedef unsigned short u16;
typedef unsigned int u32;
using bf16x8 = __attribute__((ext_vector_type(8))) short;
using s16x4  = __attribute__((ext_vector_type(4))) short;
using f32x16 = __attribute__((ext_vector_type(16))) float;
using f32x2  = __attribute__((ext_vector_type(2))) float;
using bf2_t  = __attribute__((ext_vector_type(2))) __bf16;
using u32x4  = __attribute__((ext_vector_type(4))) unsigned;
using u32x2  = __attribute__((ext_vector_type(2))) unsigned;
#define MFMA32(a, b, c) __builtin_amdgcn_mfma_f32_32x32x16_bf16((a), (b), (c), 0, 0, 0)

constexpr int T_TOK = 49152;
constexpr int L_PROMPT = 16384;
constexpr int DM = 1024;
constexpr int NCOL = 4352;
constexpr float EPS = 1e-6f;
constexpr float LOG2E = 1.4426950408889634f;
constexpr size_t MiB = 1u << 20;

constexpr size_t WS_HQ = 0;
constexpr size_t WS_GF = 48 * MiB;
constexpr size_t WS_GB = 96 * MiB;
constexpr size_t WS_HV = 144 * MiB;
constexpr size_t WS_Y = 0;
constexpr size_t WS_CVT = 192 * MiB;
constexpr size_t WS_XB = 216 * MiB;
constexpr size_t WS_OF = WS_XB;
constexpr size_t WS_OB = WS_XB + 48 * MiB;
constexpr size_t WS_R0 = 312 * MiB;
constexpr size_t WS_WIN = 408 * MiB;
constexpr size_t WS_WOUT = 425 * MiB;
constexpr size_t WS_TAB = 429 * MiB;
constexpr size_t WS_RSTD = 431 * MiB;
constexpr size_t WS_MISC = 431 * MiB + 256 * 1024;
constexpr size_t WS_HF = 432 * MiB;
constexpr size_t WS_HD = 456 * MiB;
constexpr int MISC_HCNT = 1200;
constexpr int MISC_BAR = 1400;
constexpr int MISC_BAR2 = 4096;
constexpr int MISC_GCTR = 1440;
constexpr size_t DO_BQ = 0;
constexpr size_t DO_CQ = 24 * MiB;
constexpr size_t DO_GA = 48 * MiB;
constexpr size_t DO_GB = 96 * MiB;
constexpr size_t DO_GC = 120 * MiB;
constexpr size_t DO_BK = 144 * MiB;
constexpr size_t DO_BVT = 156 * MiB;
constexpr size_t DO_CK = 168 * MiB;

constexpr float QS_GQA = 0.125f * LOG2E;
constexpr float QS_DIFF = 0.17677669529663687f * LOG2E;

struct Params {
  const float* x_prompt; const float* x_sample; const float* pre_norm_w; const float* w_in;
  const float* hgrn_lb; const float* hgrn_norm_w; const float* gqa_q_norm_w; const float* gqa_k_norm_w;
  const float* diff_lambda; const float* diff_norm_w; const float* w_out; const float* post_norm_w;
  char* out; char* ws;
  int dry; int wid;
};
DI int tidx(const Params& p) {
  int l = (int)__builtin_amdgcn_mbcnt_hi(~0u, __builtin_amdgcn_mbcnt_lo(~0u, 0u));
  asm volatile("" : "+v"(l));
  return p.wid * 64 + l;
}

DI u32 pack2bf(float lo, float hi) { f32x2 v = {lo, hi}; return __builtin_bit_cast(u32, __builtin_convertvector(v, bf2_t)); }
DI u16 f2bf(float x) { return (u16)(pack2bf(x, 0.f) & 0xffffu); }
DI float bf2f(u16 b) { return __uint_as_float(((u32)b) << 16); }
DI float bflo(u32 w) { return __uint_as_float(w << 16); }
DI float bfhi(u32 w) { return __uint_as_float(w & 0xffff0000u); }
DI u16 f2h(float x) { _Float16 h = (_Float16)x; return __builtin_bit_cast(u16, h); }
DI float h2f(u16 b) { return (float)__builtin_bit_cast(_Float16, b); }
DI unsigned xcc_id() { return (unsigned)__builtin_amdgcn_s_getreg((3 << 11) | 20) & 0xFu; }
DI int crow(int i, int h) { return (i & 3) + 8 * (i >> 2) + 4 * h; }
DI bf16x8 pack8(const f32x16& x, int s) {
  u32x4 p;
  p[0] = pack2bf(x[8 * s + 0], x[8 * s + 1]); p[1] = pack2bf(x[8 * s + 2], x[8 * s + 3]);
  p[2] = pack2bf(x[8 * s + 4], x[8 * s + 5]); p[3] = pack2bf(x[8 * s + 6], x[8 * s + 7]);
  return __builtin_bit_cast(bf16x8, p);
}
DI bf16x8 cat44(s16x4 lo, s16x4 hi) { return __builtin_shufflevector(lo, hi, 0, 1, 2, 3, 4, 5, 6, 7); }
DI float fadd1(float a, float b) { float r; asm("v_add_f32 %0, %1, %2" : "=v"(r) : "v"(a), "v"(b)); return r; }
DI float xhalf(float v) { return __shfl_xor(v, 32); }
DI float wave_sum(float v) { for (int o = 32; o; o >>= 1) v += __shfl_xor(v, o); return v; }
DI float wave_max(float v) { for (int o = 32; o; o >>= 1) v = fmaxf(v, __shfl_xor(v, o)); return v; }
DI float sigm(float x) { return __builtin_amdgcn_rcpf(1.f + __builtin_amdgcn_exp2f(-LOG2E * x)); }
DI int seq_of(int t) { return t < L_PROMPT ? 0 : 1 + ((t - L_PROMPT) >> 13); }
DI int pos_of(int t) { return t < L_PROMPT ? t : (t & 8191); }

DI void transpose_unit(const Params& p, int u, char* smem) {
  u16* tile = (u16*)smem;
  const int tid = tidx(p);
  const float* src; u16* dst; const float* rw = nullptr; int N, kt, nt;
  if (u < 2176) { int l = u / 1088, r = u % 1088; kt = r / 68; nt = r % 68; N = NCOL;
    src = p.w_in + (size_t)l * DM * NCOL; dst = (u16*)(p.ws + WS_WIN) + (size_t)l * NCOL * DM; rw = p.pre_norm_w + l * DM; }
  else { int v = u - 2176; int l = v / 256, r = v % 256; kt = r / 16; nt = r % 16; N = DM;
    src = p.w_out + (size_t)l * DM * DM; dst = (u16*)(p.ws + WS_WOUT) + (size_t)l * DM * DM; }
  const int c4 = (tid & 15) * 4, r0 = tid >> 4;
  __syncthreads();
#pragma unroll
  for (int i = 0; i < 4; ++i) {
    int r = r0 + 16 * i; int k = kt * 64 + r;
    float4 v = *(const float4*)(src + (size_t)k * N + nt * 64 + c4);
    float w = rw ? rw[k] : 1.f;
    tile[(c4 + 0) * 72 + r] = f2bf(v.x * w); tile[(c4 + 1) * 72 + r] = f2bf(v.y * w);
    tile[(c4 + 2) * 72 + r] = f2bf(v.z * w); tile[(c4 + 3) * 72 + r] = f2bf(v.w * w);
  }
  __syncthreads();
#pragma unroll
  for (int i = 0; i < 2; ++i) {
    int n = (tid >> 3) + 32 * i, ch = tid & 7;
    u32x4 v = *(const u32x4*)(tile + n * 72 + ch * 8);
    *(u32x4*)(dst + (size_t)(nt * 64 + n) * DM + kt * 64 + ch * 8) = v;
  }
}

DI void sincos_d(double x, float& c, float& s) {
  const double x2 = x * x;
  double ts = 0.0, tc = 0.0;
#pragma unroll
  for (int n = 14; n >= 1; --n) {
    const double cs_ = -1.0 / (double)((2 * n) * (2 * n + 1));
    const double cc_ = -1.0 / (double)((2 * n - 1) * (2 * n));
    ts = (1.0 + ts) * (x2 * cs_);
    tc = (1.0 + tc) * (x2 * cc_);
  }
  c = (float)(1.0 + tc); s = (float)(x * (1.0 + ts));
}

DI void table_unit(const Params& p, int u) {
  int idx = u * 256 + tidx(p);
  int i = idx >> 14, pos = idx & 16383;
  const int i4 = i & 3, i16 = i >> 2;
  double inv = i4 == 0 ? 1.0 : (i4 == 1 ? 0.5623413251903491 : (i4 == 2 ? 0.31622776601683794 : 0.1778279410038923));
  inv *= i16 == 0 ? 1.0 : (i16 == 1 ? 0.1 : (i16 == 2 ? 0.01 : 0.001));
  double ang = (double)pos * inv;
  double rev = ang * 0.15915494309189535;
  rev -= rint(rev);
  float c, s; sincos_d(rev * 6.283185307179586, c, s);
  ((float2*)(p.ws + WS_TAB))[idx] = make_float2(c, s);
}

using f32x4v = __attribute__((ext_vector_type(4))) float;
DI float4 ntload4(const float* ptr) { f32x4v v = __builtin_nontemporal_load((const f32x4v*)ptr); return make_float4(v[0], v[1], v[2], v[3]); }
DI const float* x_row(const Params& p, int row) {
  return row < L_PROMPT ? p.x_prompt + (size_t)row * DM : p.x_sample + (size_t)(row - L_PROMPT) * DM;
}

DI void rowprep(const Params& p, int mode) {
  const int wave = tidx(p) >> 6, lane = tidx(p) & 63;
  const u16* yb = (const u16*)(p.ws + WS_Y);
  u16* r0b = (u16*)(p.ws + WS_R0);
  u16* xb = (u16*)(p.ws + WS_XB);
  float* rstd = (float*)(p.ws + WS_RSTD);
  const float* pw = p.post_norm_w + (mode == 2 ? DM : 0);
  for (int row = blockIdx.x * 4 + wave; row < T_TOK; row += gridDim.x * 4) {
    const float* x0 = x_row(p, row);
    float4 xv[4];
#pragma unroll
    for (int i = 0; i < 4; ++i) xv[i] = ntload4(x0 + lane * 4 + 256 * i);
    if (mode >= 1) {
      float4 yv[4]; float ss = 0.f;
#pragma unroll
      for (int i = 0; i < 4; ++i) {
        { u32x2 yp = *(const u32x2*)(yb + (size_t)row * DM + lane * 4 + 256 * i);
          yv[i] = make_float4(bflo(yp[0]), bfhi(yp[0]), bflo(yp[1]), bfhi(yp[1])); }
        ss += yv[i].x * yv[i].x + yv[i].y * yv[i].y + yv[i].z * yv[i].z + yv[i].w * yv[i].w;
      }
      ss = wave_sum(ss);
      float rs = rsqrtf(ss * (1.f / DM) + EPS);
#pragma unroll
      for (int i = 0; i < 4; ++i) {
        float4 w = *(const float4*)(pw + lane * 4 + 256 * i);
        float4 r = make_float4(yv[i].x * rs * w.x, yv[i].y * rs * w.y, yv[i].z * rs * w.z, yv[i].w * rs * w.w);
        size_t off = (size_t)row * DM + lane * 4 + 256 * i;
        if (mode == 1) {
          u16 h0 = f2h(r.x), h1 = f2h(r.y), h2 = f2h(r.z), h3 = f2h(r.w);
          u32x2 pk = {(u32)h0 | ((u32)h1 << 16), (u32)h2 | ((u32)h3 << 16)};
          __builtin_nontemporal_store(pk, (u32x2*)(r0b + off));
          xv[i].x += h2f(h0); xv[i].y += h2f(h1); xv[i].z += h2f(h2); xv[i].w += h2f(h3);
        } else {
          u32x2 pk = *(const u32x2*)(r0b + off);
          float4 o;
          o.x = (xv[i].x + h2f((u16)(pk[0] & 0xffff))) + r.x;
          o.y = (xv[i].y + h2f((u16)(pk[0] >> 16))) + r.y;
          o.z = (xv[i].z + h2f((u16)(pk[1] & 0xffff))) + r.z;
          o.w = (xv[i].w + h2f((u16)(pk[1] >> 16))) + r.w;
          { f32x4v ov = {o.x, o.y, o.z, o.w}; __builtin_nontemporal_store(ov, (f32x4v*)((float*)p.out + off)); }
        }
      }
    }
    if (mode <= 1) {
      float ss = 0.f;
#pragma unroll
      for (int i = 0; i < 4; ++i) {
        ss += xv[i].x * xv[i].x + xv[i].y * xv[i].y + xv[i].z * xv[i].z + xv[i].w * xv[i].w;
        u32x2 pk = {pack2bf(xv[i].x, xv[i].y), pack2bf(xv[i].z, xv[i].w)};
        *(u32x2*)(xb + (size_t)row * DM + lane * 4 + 256 * i) = pk;
      }
      ss = wave_sum(ss);
      if (lane == 0) rstd[row] = rsqrtf(ss * (1.f / DM) + EPS);
    }
  }
}

DI void phase0(const Params& p, char* smem) {
  const int nb = gridDim.x, b = blockIdx.x;
  for (int u = b; u < 2688; u += nb) transpose_unit(p, u, smem);
  for (int u = b; u < 1024; u += nb) table_unit(p, u);
  rowprep(p, 0);
  if (b == 0) {
    u32* misc = (u32*)(p.ws + WS_MISC);
    float* miscf = (float*)misc;
    const int tid = tidx(p);
    if (tid < 104) misc[tid] = 0u;
    if (tid < 96) misc[MISC_HCNT + tid] = 0u;
    for (int i = tid; i < 1100; i += 256) misc[MISC_BAR2 + i] = 0u;
    if (tid < 32) misc[MISC_GCTR + tid] = 0u;
    if (tid < 2) {
      const float* lp = p.diff_lambda + tid * 128;
      float a = 0.f, c = 0.f;
      for (int i = 0; i < 32; ++i) { a += lp[i] * lp[32 + i]; c += lp[64 + i] * lp[96 + i]; }
      float lam_init = 0.8f - 0.6f * expf(-0.3f * (float)tid);
      miscf[104 + tid] = expf(a) - expf(c) + lam_init;
    }
    for (int i = tid; i < 1024; i += 256) {
      float a0 = p.hgrn_lb[i], a1 = p.hgrn_lb[1024 + i];
      miscf[128 + i] = 1.f / (1.f + expf(a0 - a1));
    }
  }
}

constexpr int HS = 136;
constexpr int VS = 40;
constexpr int H_QM = 0, H_KM = 8704, H_QB = 17408, H_KLT = 26112, H_VT = 36352, H_DEC = 46592;
constexpr int H_RAW = 47104;
constexpr int SMEM_BYTES = 47104 + 32768 + 16;
constexpr int GS = 72;
constexpr int CS = 136;

enum { K_SILU = 0, K_COPY, K_G, K_QN, K_KN, K_VT, K_CQ, K_CK };

struct TileDesc { int kind; u16* dst; int stride; int col; int aux; };

DI TileDesc tile_desc(const Params& p, int nt) {
  TileDesc d; d.aux = 0;
  char* ws = p.ws; char* o = p.out;
  if (nt < 4)       { d.kind = K_SILU; d.dst = (u16*)(ws + WS_HQ); d.stride = 512; d.col = nt * 128; }
  else if (nt < 8)  { d.kind = K_G;    d.dst = (u16*)(ws + WS_GF); d.stride = 512; d.col = (nt - 4) * 128; d.aux = 0; }
  else if (nt < 12) { d.kind = K_G;    d.dst = (u16*)(ws + WS_GB); d.stride = 512; d.col = (nt - 8) * 128; d.aux = 1; }
  else if (nt < 16) { d.kind = K_COPY; d.dst = (u16*)(ws + WS_HV); d.stride = 512; d.col = (nt - 12) * 128; }
  else if (nt < 20) { d.kind = K_SILU; d.dst = (u16*)(o + DO_GA);  d.stride = 512; d.col = (nt - 16) * 128; }
  else if (nt < 22) { d.kind = K_QN;   d.dst = (u16*)(o + DO_BQ);  d.stride = 256; d.col = (nt - 20) * 128; }
  else if (nt < 23) { d.kind = K_KN;   d.dst = (u16*)(o + DO_BK);  d.stride = 128; d.col = 0; }
  else if (nt < 24) { d.kind = K_VT;   d.dst = (u16*)(o + DO_BVT); d.stride = T_TOK; d.col = 0; }
  else if (nt < 26) { d.kind = K_SILU; d.dst = (u16*)(o + DO_GB);  d.stride = 256; d.col = (nt - 24) * 128; }
  else if (nt < 28) { d.kind = K_CQ;   d.dst = (u16*)(o + DO_CQ);  d.stride = 256; d.col = (nt - 26) * 128; }
  else if (nt < 30) { d.kind = K_CK;   d.dst = (u16*)(o + DO_CK);  d.stride = 256; d.col = (nt - 28) * 128; d.aux = (nt - 28); }
  else if (nt < 32) { d.kind = K_VT;   d.dst = (u16*)(ws + WS_CVT); d.stride = T_TOK; d.col = (nt - 30) * 128; }
  else              { d.kind = K_SILU; d.dst = (u16*)(o + DO_GC);  d.stride = 256; d.col = (nt - 32) * 128; }
  return d;
}

DI void rope_pairs(f32x16& x, const float2* tab, int pos, int h, float scale) {
#pragma unroll
  for (int i = 0; i < 8; ++i) {
    int idx = crow(i, h);
    float2 cs = tab[idx * 16384 + pos];
    float a = x[i], b = x[i + 8];
    x[i] = (a * cs.x - b * cs.y) * scale;
    x[i + 8] = (b * cs.x + a * cs.y) * scale;
  }
}

DI void rope32(float* x, const float2* tab, int pos, float scale) {
#pragma unroll
  for (int j = 0; j < 16; ++j) {
    float2 cs = tab[j * 16384 + pos];
    float a = x[j], b = x[j + 16];
    x[j] = (a * cs.x - b * cs.y) * scale;
    x[j + 16] = (b * cs.x + a * cs.y) * scale;
  }
}
DI void qk_post(const Params& p, int layer, int nt, int t0, int tid, char* smem) {
  const float2* tab = (const float2*)(p.ws + WS_TAB);
  u32* misc = (u32*)(p.ws + WS_MISC);
  const int tl = tid & 127, hh = __builtin_amdgcn_readfirstlane(tid >> 7), lane = tid & 63;
  const int pos = pos_of(t0 + tl), seq = seq_of(t0);
#pragma unroll 1
  for (int hf = 0; hf < 2; ++hf) {
    const TileDesc d = tile_desc(p, nt * 2 + hf);
    if (d.kind != K_QN && d.kind != K_KN && d.kind != K_CQ && d.kind != K_CK) continue;
    u16* row = (u16*)(smem + hf * 34816) + tl * CS + hh * 64;
    float x[64];
#pragma unroll
    for (int c = 0; c < 8; ++c) {
      u32x4 v = *(const u32x4*)(row + c * 8);
#pragma unroll
      for (int i = 0; i < 4; ++i) { x[c * 8 + 2 * i] = bflo(v[i]); x[c * 8 + 2 * i + 1] = bfhi(v[i]); }
    }
    if (d.kind == K_QN || d.kind == K_KN) {
      const float* nw = (d.kind == K_QN ? p.gqa_q_norm_w : p.gqa_k_norm_w) + layer * 64;
      float ss = 0.f;
#pragma unroll
      for (int j = 0; j < 64; ++j) ss += x[j] * x[j];
      const float rn = rsqrtf(ss * (1.f / 64.f) + EPS);
      float s2 = 0.f;
#pragma unroll
      for (int j = 0; j < 64; ++j) { x[j] *= rn * nw[j]; s2 += x[j] * x[j]; }
      const float sc = d.kind == K_QN ? QS_GQA : 1.f;
      rope32(x, tab, pos >> 6, sc);
      rope32(x + 32, tab, pos & 63, sc);
      if (d.kind == K_KN) {
        s2 = wave_max(s2);
        if (lane == 0) atomicMax(&misc[layer * 50 + seq * 10 + hh], __float_as_uint(s2 * 1.02f));
      }
    } else {
      const float sc = d.kind == K_CQ ? QS_DIFF : 1.f;
      if (d.kind == K_CK) {
#pragma unroll
        for (int m = 0; m < 2; ++m) {
          float s2 = 0.f;
#pragma unroll
          for (int j = 0; j < 32; ++j) s2 += x[m * 32 + j] * x[m * 32 + j];
          s2 = wave_max(s2);
          if (lane == 0) atomicMax(&misc[layer * 50 + seq * 10 + 2 + (d.aux * 2 + hh) * 2 + m], __float_as_uint(s2 * 1.02f));
        }
      }
      rope32(x, tab, pos, sc);
      rope32(x + 32, tab, pos, sc);
    }
#pragma unroll
    for (int c = 0; c < 8; ++c) {
      u32x4 v;
#pragma unroll
      for (int i = 0; i < 4; ++i) v[i] = pack2bf(x[c * 8 + 2 * i], x[c * 8 + 2 * i + 1]);
      *(u32x4*)(row + c * 8) = v;
    }
  }
  __syncthreads();
}

constexpr int G_STAGE = 24576;
DI int gswz(int row, int lc) { return row * 32 + ((lc ^ ((row >> 2) & 3)) << 3); }

template <bool IN_PROJ>
DI void gemm_tile(const Params& p, int layer, int nt, int tt, char* smem) {
  int tid = tidx(p);
  asm volatile("" : "+v"(tid));
  const int w = __builtin_amdgcn_readfirstlane(tid >> 6), lane = tid & 63, r = lane & 31, h = lane >> 5;
  const int wf = w >> 1, wt = w & 1;
  const int n0 = nt * 256, t0 = tt * 128;
  const u16* Wt = IN_PROJ ? (const u16*)(p.ws + WS_WIN) + (size_t)layer * NCOL * DM
                          : (const u16*)(p.ws + WS_WOUT) + (size_t)layer * DM * DM;
  const u16* xb = (const u16*)(p.ws + WS_XB);
  const u16* mixA = (const u16*)(p.ws + WS_OF);
  const u16* mixB = (const u16*)(p.out + DO_BQ);
  const u16* mixC = (const u16*)(p.out + DO_CQ);

  f32x16 acc[4][2];
#pragma unroll
  for (int a = 0; a < 4; ++a)
#pragma unroll
    for (int b = 0; b < 2; ++b)
#pragma unroll
      for (int i = 0; i < 16; ++i) acc[a][b][i] = 0.f;

  auto stage = [&](int kt) {
    const int k0 = kt * 32;
    char* base = smem + (kt % 3) * G_STAGE;
#pragma unroll
    for (int i = 0; i < 4; ++i) {
      int c = tid + 256 * i; int row = c >> 2, lc = (c & 3) ^ ((row >> 2) & 3);
      __builtin_amdgcn_global_load_lds((const unsigned*)(Wt + (size_t)(n0 + row) * DM + k0 + lc * 8), (unsigned*)(base + c * 16), 16, 0, 0);
    }
#pragma unroll
    for (int i = 0; i < 2; ++i) {
      int c = tid + 256 * i; int row = c >> 2, lc = (c & 3) ^ ((row >> 2) & 3);
      const u16* bp;
      if (IN_PROJ) bp = xb + (size_t)(t0 + row) * DM + k0 + lc * 8;
      else {
        if (k0 < 512) bp = mixA + (size_t)(t0 + row) * 512 + k0 + lc * 8;
        else if (k0 < 768) bp = mixB + (size_t)(t0 + row) * 256 + (k0 - 512) + lc * 8;
        else bp = mixC + (size_t)(t0 + row) * 256 + (k0 - 768) + lc * 8;
      }
      __builtin_amdgcn_global_load_lds((const unsigned*)bp, (unsigned*)(base + 16384 + c * 16), 16, 0, 0);
    }
  };
  asm volatile("s_waitcnt vmcnt(0)" ::: "memory");
  __syncthreads();
  stage(0); stage(1); stage(2);
  auto load_frags = [&](int kt, int ks, bf16x8 (&fa)[4], bf16x8 (&fb)[2]) {
    const u16* sA = (const u16*)(smem + (kt % 3) * G_STAGE);
    const u16* sB = sA + 8192;
#pragma unroll
    for (int fi = 0; fi < 4; ++fi) fa[fi] = *(const bf16x8*)(sA + gswz(wf * 128 + fi * 32 + r, ks * 2 + h));
#pragma unroll
    for (int ti = 0; ti < 2; ++ti) fb[ti] = *(const bf16x8*)(sB + gswz(wt * 64 + ti * 32 + r, ks * 2 + h));
  };
  auto mma = [&](const bf16x8 (&fa)[4], const bf16x8 (&fb)[2]) {
#pragma unroll
    for (int fi = 0; fi < 4; ++fi)
#pragma unroll
      for (int ti = 0; ti < 2; ++ti) acc[fi][ti] = MFMA32(fa[fi], fb[ti], acc[fi][ti]);
  };
  bf16x8 fa0[4], fb0[2], fa1[4], fb1[2];
  asm volatile("s_waitcnt vmcnt(12)" ::: "memory");
  __syncthreads();
  load_frags(0, 0, fa0, fb0);
  for (int kt = 0; kt < 32; ++kt) {
    load_frags(kt, 1, fa1, fb1);
    mma(fa0, fb0);
    if (kt + 1 < 32) {
      if (kt + 2 < 32) asm volatile("s_waitcnt vmcnt(6) lgkmcnt(0)" ::: "memory");
      else asm volatile("s_waitcnt vmcnt(0) lgkmcnt(0)" ::: "memory");
      __syncthreads();
      if (kt + 3 < 32) stage(kt + 3);
      load_frags(kt + 1, 0, fa0, fb0);
    }
    mma(fa1, fb1);
  }
  __syncthreads();

  if (!IN_PROJ) {
    u16* yb = (u16*)(p.ws + WS_Y);
    u16* sC = (u16*)(smem + wf * 34816);
#pragma unroll
    for (int fi = 0; fi < 4; ++fi)
#pragma unroll
      for (int ti = 0; ti < 2; ++ti)
#pragma unroll
        for (int g = 0; g < 4; ++g) {
          u32x2 pk = {pack2bf(acc[fi][ti][4 * g], acc[fi][ti][4 * g + 1]), pack2bf(acc[fi][ti][4 * g + 2], acc[fi][ti][4 * g + 3])};
          *(u32x2*)(sC + (wt * 64 + ti * 32 + r) * CS + fi * 32 + 8 * g + 4 * h) = pk;
        }
    __syncthreads();
#pragma unroll
    for (int hf = 0; hf < 2; ++hf) {
      const u16* sH = (const u16*)(smem + hf * 34816);
#pragma unroll
      for (int i = 0; i < 8; ++i) {
        int c = tid + 256 * i; int row = c >> 4, cc = c & 15;
        u32x4 v = *(const u32x4*)(sH + row * CS + cc * 8);
        *(u32x4*)(yb + (size_t)(t0 + row) * DM + n0 + hf * 128 + cc * 8) = v;
      }
    }
    return;
  }

  const TileDesc d = tile_desc(p, nt * 2 + wf);
  const float* rstd = (const float*)(p.ws + WS_RSTD);
  u32* misc = (u32*)(p.ws + WS_MISC);
  const float* miscf = (const float*)misc;
  u16* sC = (u16*)(smem + wf * 34816);
#pragma unroll
  for (int ti = 0; ti < 2; ++ti) {
    const int t = t0 + wt * 64 + ti * 32 + r;
    const float rs = rstd[t];
#pragma unroll
    for (int fi = 0; fi < 4; ++fi)
#pragma unroll
      for (int i = 0; i < 16; ++i) acc[fi][ti][i] *= rs;
    if (d.kind == K_SILU) {
#pragma unroll
      for (int fi = 0; fi < 4; ++fi)
#pragma unroll
        for (int i = 0; i < 16; ++i) { float x = acc[fi][ti][i]; acc[fi][ti][i] = x * sigm(x); }
    } else if (d.kind == K_G) {
#pragma unroll
      for (int fi = 0; fi < 4; ++fi)
#pragma unroll
        for (int g = 0; g < 4; ++g) {
          float4 lb4 = make_float4(0.f, 0.f, 0.f, 0.f);
          if (layer != 0) lb4 = *(const float4*)(miscf + 128 + d.aux * 512 + d.col + fi * 32 + 8 * g + 4 * h);
          acc[fi][ti][4 * g] = __logf(lb4.x + (1.f - lb4.x) * sigm(acc[fi][ti][4 * g]));
          acc[fi][ti][4 * g + 1] = __logf(lb4.y + (1.f - lb4.y) * sigm(acc[fi][ti][4 * g + 1]));
          acc[fi][ti][4 * g + 2] = __logf(lb4.z + (1.f - lb4.z) * sigm(acc[fi][ti][4 * g + 2]));
          acc[fi][ti][4 * g + 3] = __logf(lb4.w + (1.f - lb4.w) * sigm(acc[fi][ti][4 * g + 3]));
        }
    }
    if (d.kind == K_VT) {
      const int rp = (r & ~12) | ((r & 4) << 1) | ((r & 8) >> 1);
#pragma unroll
      for (int fi = 0; fi < 4; ++fi)
#pragma unroll
        for (int i = 0; i < 16; ++i)
          sC[(fi * 32 + crow(i, h)) * CS + wt * 64 + ti * 32 + rp] = f2bf(acc[fi][ti][i]);
    } else {
#pragma unroll
      for (int fi = 0; fi < 4; ++fi)
#pragma unroll
        for (int g = 0; g < 4; ++g) {
          u32x2 pk;
          if (d.kind == K_G) {
            pk[0] = (u32)f2h(acc[fi][ti][4 * g]) | ((u32)f2h(acc[fi][ti][4 * g + 1]) << 16);
            pk[1] = (u32)f2h(acc[fi][ti][4 * g + 2]) | ((u32)f2h(acc[fi][ti][4 * g + 3]) << 16);
          } else {
            pk[0] = pack2bf(acc[fi][ti][4 * g], acc[fi][ti][4 * g + 1]);
            pk[1] = pack2bf(acc[fi][ti][4 * g + 2], acc[fi][ti][4 * g + 3]);
          }
          *(u32x2*)(sC + (wt * 64 + ti * 32 + r) * CS + fi * 32 + 8 * g + 4 * h) = pk;
        }
    }
  }
  __syncthreads();
  if (nt == 10 || nt == 11 || nt == 13 || nt == 14) qk_post(p, layer, nt, t0, tid, smem);
#pragma unroll
  for (int hf = 0; hf < 2; ++hf) {
    const TileDesc dd = tile_desc(p, nt * 2 + hf);
    const u16* sH = (const u16*)(smem + hf * 34816);
#pragma unroll
    for (int i = 0; i < 8; ++i) {
      int c = tid + 256 * i; int row = c >> 4, cc = c & 15;
      u32x4 v = *(const u32x4*)(sH + row * CS + cc * 8);
      if (dd.kind == K_VT) *(u32x4*)(dd.dst + (size_t)(dd.col + row) * T_TOK + t0 + cc * 8) = v;
      else *(u32x4*)(dd.dst + (size_t)(t0 + row) * dd.stride + dd.col + cc * 8) = v;
    }
  }
}

template <bool IN_PROJ>
DI void gemm_phase(const Params& p, int layer, char* smem) {
  constexpr int NT = IN_PROJ ? 17 : 4;
  constexpr int PER_XCD = 48 * NT;
  u32* ctr = (u32*)(p.ws + WS_MISC) + MISC_GCTR + layer * 16 + (IN_PROJ ? 0 : 8);
  int* s_tile = (int*)(smem + SMEM_BYTES - 16);
  const int x0 = (int)xcc_id() & 7;
  for (int a = 0; a < 8; ++a) {
    const int xq = (x0 + a) & 7;
    for (;;) {
      __syncthreads();
      if (tidx(p) == 0) *s_tile = (int)atomicAdd(ctr + xq, 1u);
      __syncthreads();
      const int q = __builtin_amdgcn_readfirstlane(*s_tile);
      if (q >= PER_XCD) break;
      int grp = q / (8 * NT), rem = q % (8 * NT);
      int nt = rem >> 3; int ttl = grp * 8 + (rem & 7);
      int tt = ttl * 8 + xq;
      gemm_tile<IN_PROJ>(p, layer, nt, tt, smem);
    }
  }
}


constexpr int HSEG = 128;
constexpr int H_UNITS = 96;

template <int PASS>
DI void hgrn_unit(const Params& p, int layer, int unit, char* smem) {
  int seq, grp, seg, nseg, ubase;
  if (unit < 32) { seq = 0; grp = unit >> 2; seg = unit & 3; nseg = 4; ubase = unit & ~3; }
  else { int u = unit - 32; seq = 1 + (u >> 4); grp = (u & 15) >> 1; seg = u & 1; nseg = 2; ubase = unit & ~1; }
  const int hd = grp >> 1, dir = grp & 1;
  const int seq_start = seq == 0 ? 0 : L_PROMPT + (seq - 1) * 8192;
  const int nch = nseg * HSEG;
  int tid = tidx(p);
  asm volatile("" : "+v"(tid));
  const int w = __builtin_amdgcn_readfirstlane(tid >> 6), lane = tid & 63, r = lane & 31, h = lane >> 5;
  const int d = tid & 127, half = tid >> 7;
  const u16* gq = (const u16*)(p.ws + WS_HQ) + hd * 128;
  const u16* gg = (const u16*)(p.ws + (dir ? WS_GB : WS_GF)) + hd * 128;
  const u16* gv = (const u16*)(p.ws + WS_HV) + hd * 128;
  u16* od = (u16*)(p.ws + (dir ? WS_OB : WS_OF));
  u16* sQm = (u16*)(smem + H_QM); u16* sKm = (u16*)(smem + H_KM); u16* sQb = (u16*)(smem + H_QB);
  u16* sKlT = (u16*)(smem + H_KLT); u16* sVt = (u16*)(smem + H_VT);
  float* sDec = (float*)(smem + H_DEC);
  float* HF = (float*)(p.ws + WS_HF); float* HD = (float*)(p.ws + WS_HD);
  u32* cnt = (u32*)(p.ws + WS_MISC) + MISC_HCNT + layer * 40 + seq * 8 + grp;

  f32x16 S[4];
#pragma unroll
  for (int b = 0; b < 4; ++b)
#pragma unroll
    for (int i = 0; i < 16; ++i) S[b][i] = 0.f;

  auto chunk_t0 = [&](int c) { return seq_start + (dir ? (nch - 1 - c) : c) * 32; };
  char* rawW = smem + H_RAW + w * 8192;
  const int dcol = (w & 1) * 64;
  auto gl = [&](int c) {
    const int t0 = chunk_t0(c);
    const int row8 = lane >> 3, ch = lane & 7;
#pragma unroll
    for (int i = 0; i < 4; ++i) {
      int j = 8 * i + row8;
      size_t off = (size_t)(dir ? t0 + 31 - j : t0 + j) * 512 + dcol + ch * 8;
      __builtin_amdgcn_global_load_lds((const unsigned*)(gg + off), (unsigned*)(rawW + i * 1024 + lane * 16), 16, 0, 0);
    }
#pragma unroll
    for (int i = 0; i < 2; ++i) {
      int j = half * 16 + 8 * i + row8;
      size_t off = (size_t)(dir ? t0 + 31 - j : t0 + j) * 512 + dcol + ch * 8;
      if (PASS == 2) __builtin_amdgcn_global_load_lds((const unsigned*)(gq + off), (unsigned*)(rawW + 4096 + i * 1024 + lane * 16), 16, 0, 0);
      __builtin_amdgcn_global_load_lds((const unsigned*)(gv + off), (unsigned*)(rawW + 6144 + i * 1024 + lane * 16), 16, 0, 0);
    }
  };
  const int c_begin = seg * HSEG, c_end = c_begin + HSEG;
  __syncthreads();
  gl(c_begin);
  if (PASS == 2 && seg > 0) {
    if (tid == 0) { while (__hip_atomic_load(cnt, __ATOMIC_RELAXED, __HIP_MEMORY_SCOPE_AGENT) < (u32)nseg) __builtin_amdgcn_s_sleep(8); }
    __syncthreads();
    __threadfence();
    for (int j = 0; j < seg; ++j) {
      const float* Fj = HF + ((size_t)(ubase + j) * 256 + tid) * 64;
      const float* Dj = HD + (size_t)(ubase + j) * 128;
#pragma unroll
      for (int db = 0; db < 4; ++db)
#pragma unroll
        for (int g = 0; g < 4; ++g) {
          float4 dc = *(const float4*)(Dj + db * 32 + 8 * g + 4 * h);
          float4 f = *(const float4*)(Fj + db * 16 + 4 * g);
          S[db][4 * g] = S[db][4 * g] * dc.x + f.x; S[db][4 * g + 1] = S[db][4 * g + 1] * dc.y + f.y;
          S[db][4 * g + 2] = S[db][4 * g + 2] * dc.z + f.z; S[db][4 * g + 3] = S[db][4 * g + 3] * dc.w + f.w;
        }
    }
  }
  float logD = 0.f;
  for (int c = c_begin; c < c_end; ++c) {
    const int t0 = chunk_t0(c);
    asm volatile("s_waitcnt vmcnt(0)" ::: "memory");
    const u16* rG = (const u16*)rawW; const u16* rQ = rG + 2048; const u16* rV = rG + 3072;
    float tot0 = 0.f, tot1 = 0.f, g16;
    float gval[16]; u16 qraw[16], vraw[16];
#pragma unroll
    for (int j = 0; j < 32; ++j) {
      float g = h2f(rG[j * 64 + lane]);
      if (j < 16) tot0 += g; else tot1 += g;
      if (j == 16) g16 = g;
      if ((j >> 4) == half) gval[j & 15] = g;
    }
#pragma unroll
    for (int jj = 0; jj < 16; ++jj) { if (PASS == 2) qraw[jj] = rQ[jj * 64 + lane]; vraw[jj] = rV[jj * 64 + lane]; }
    asm volatile("s_waitcnt lgkmcnt(0)" ::: "memory");
    __builtin_amdgcn_sched_barrier(0);
    if (c + 1 < c_end) gl(c + 1);
    __syncthreads();
    const float bmid = tot0 + g16, blast = tot0 + tot1;
    logD += blast;
    float run = half ? tot0 : 0.f;
    u32 klp[8], vtp[8];
    if (PASS == 2) {
      const float Emid = __expf(bmid), Elm = __expf(blast - bmid);
#pragma unroll
      for (int jj = 0; jj < 16; jj += 2) {
        float kl2[2];
#pragma unroll
        for (int u = 0; u < 2; ++u) {
          const int j = half * 16 + jj + u;
          run += gval[jj + u];
          float e1 = __expf(run - bmid), e2 = __expf(bmid - run);
          float q = bf2f(qraw[jj + u]);
          float k = 1.f - __expf(gval[jj + u]);
          float qm = q * e1, km = k * e2;
          kl2[u] = km * Elm;
          sQm[j * HS + d] = f2bf(qm); sKm[j * HS + d] = f2bf(km); sQb[j * HS + d] = f2bf(qm * Emid);
        }
        klp[jj >> 1] = pack2bf(kl2[0], kl2[1]);
      }
    } else {
#pragma unroll
      for (int jj = 0; jj < 16; jj += 2) {
        float kl2[2];
#pragma unroll
        for (int u = 0; u < 2; ++u) {
          run += gval[jj + u];
          kl2[u] = (1.f - __expf(gval[jj + u])) * __expf(blast - run);
        }
        klp[jj >> 1] = pack2bf(kl2[0], kl2[1]);
      }
    }
#pragma unroll
    for (int jj = 0; jj < 16; jj += 2)
      vtp[jj >> 1] = (u32)vraw[jj] | ((u32)vraw[jj + 1] << 16);
    {
      u32x4 a = {klp[0], klp[1], klp[2], klp[3]}, b = {klp[4], klp[5], klp[6], klp[7]};
      *(u32x4*)(sKlT + d * VS + half * 16) = a; *(u32x4*)(sKlT + d * VS + half * 16 + 8) = b;
      u32x4 c0 = {vtp[0], vtp[1], vtp[2], vtp[3]}, c1 = {vtp[4], vtp[5], vtp[6], vtp[7]};
      *(u32x4*)(sVt + d * VS + half * 16) = c0; *(u32x4*)(sVt + d * VS + half * 16 + 8) = c1;
    }
    if (half) sDec[d] = __expf(blast);
    __syncthreads();
    if (PASS == 2) {
      f32x16 at, oT;
#pragma unroll
      for (int i = 0; i < 16; ++i) { at[i] = 0.f; oT[i] = 0.f; }
#pragma unroll
      for (int ks = 0; ks < 8; ++ks) {
        bf16x8 a = *(const bf16x8*)(sKm + r * HS + ks * 16 + 8 * h);
        bf16x8 b = *(const bf16x8*)(sQm + r * HS + ks * 16 + 8 * h);
        at = MFMA32(a, b, at);
      }
#pragma unroll
      for (int i = 0; i < 16; ++i) if (crow(i, h) > r) at[i] = 0.f;
#pragma unroll
      for (int db = 0; db < 4; ++db)
#pragma unroll
        for (int s2 = 0; s2 < 2; ++s2) {
          bf16x8 a = pack8(S[db], s2);
          s16x4 lo = *(const s16x4*)(sQb + r * HS + db * 32 + s2 * 16 + 4 * h);
          s16x4 hi = *(const s16x4*)(sQb + r * HS + db * 32 + s2 * 16 + 8 + 4 * h);
          oT = MFMA32(a, cat44(lo, hi), oT);
        }
#pragma unroll
      for (int ks = 0; ks < 2; ++ks) {
        s16x4 lo = *(const s16x4*)(sVt + (32 * w + r) * VS + 16 * ks + 4 * h);
        s16x4 hi = *(const s16x4*)(sVt + (32 * w + r) * VS + 16 * ks + 8 + 4 * h);
        oT = MFMA32(cat44(lo, hi), pack8(at, ks), oT);
      }
      int tok = dir ? t0 + 31 - r : t0 + r;
#pragma unroll
      for (int g = 0; g < 4; ++g) {
        u32x2 pk = {pack2bf(oT[4 * g], oT[4 * g + 1]), pack2bf(oT[4 * g + 2], oT[4 * g + 3])};
        *(u32x2*)(od + (size_t)tok * 512 + hd * 128 + 32 * w + 8 * g + 4 * h) = pk;
      }
    }
    if (PASS == 1 || c + 1 < c_end) {
#pragma unroll
      for (int db = 0; db < 4; ++db) {
#pragma unroll
        for (int g = 0; g < 4; ++g) {
          float4 dc = *(const float4*)(sDec + db * 32 + 8 * g + 4 * h);
          S[db][4 * g] *= dc.x; S[db][4 * g + 1] *= dc.y; S[db][4 * g + 2] *= dc.z; S[db][4 * g + 3] *= dc.w;
        }
#pragma unroll
        for (int ks = 0; ks < 2; ++ks) {
          bf16x8 a = *(const bf16x8*)(sKlT + (db * 32 + r) * VS + 16 * ks + 8 * h);
          bf16x8 b = *(const bf16x8*)(sVt + (32 * w + r) * VS + 16 * ks + 8 * h);
          S[db] = MFMA32(a, b, S[db]);
        }
      }
    }
  }
  if (PASS == 1) {
    float* Fu = HF + ((size_t)unit * 256 + tid) * 64;
#pragma unroll
    for (int db = 0; db < 4; ++db)
#pragma unroll
      for (int g = 0; g < 4; ++g)
        *(float4*)(Fu + db * 16 + 4 * g) = make_float4(S[db][4 * g], S[db][4 * g + 1], S[db][4 * g + 2], S[db][4 * g + 3]);
    if (half == 0) HD[(size_t)unit * 128 + d] = __expf(logD);
    __threadfence();
    __syncthreads();
    if (tid == 0) atomicAdd(cnt, 1u);
  }
}

DI void hgrn_finalize(const Params& p, int layer) {
  const int wave = tidx(p) >> 6, lane = tidx(p) & 63;
  u16* of = (u16*)(p.ws + WS_OF); const u16* ob = (const u16*)(p.ws + WS_OB);
  const u16* ga = (const u16*)(p.out + DO_GA);
  const float* nw = p.hgrn_norm_w + layer * 512 + lane * 8;
  float wv[8];
#pragma unroll
  for (int i = 0; i < 8; ++i) wv[i] = nw[i];
  for (int t = blockIdx.x * 4 + wave; t < T_TOK; t += gridDim.x * 4) {
    size_t off = (size_t)t * 512 + lane * 8;
    u32x4 a = *(const u32x4*)(of + off), b = *(const u32x4*)(ob + off), g = *(const u32x4*)(ga + off);
    float v[8]; float ss = 0.f;
#pragma unroll
    for (int i = 0; i < 4; ++i) {
      v[2 * i] = bflo(a[i]) + bflo(b[i]); v[2 * i + 1] = bfhi(a[i]) + bfhi(b[i]);
      ss += v[2 * i] * v[2 * i] + v[2 * i + 1] * v[2 * i + 1];
    }
    ss += __shfl_xor(ss, 1); ss += __shfl_xor(ss, 2); ss += __shfl_xor(ss, 4); ss += __shfl_xor(ss, 8);
    float rn = rsqrtf(ss * (1.f / 128.f) + EPS);
    u32x4 o;
#pragma unroll
    for (int i = 0; i < 4; ++i)
      o[i] = pack2bf(v[2 * i] * rn * wv[2 * i] * bflo(g[i]), v[2 * i + 1] * rn * wv[2 * i + 1] * bfhi(g[i]));
    *(u32x4*)(of + off) = o;
  }
}

DI int swz(int row, int lc) { return row * 64 + ((lc ^ ((row >> 1) & 7)) << 3); }

template <int NKS>
DI void attn_tile(const Params& p, int layer, int seq, int slot, int qt, char* smem, bool wr = true) {
  int tid = tidx(p);
  asm volatile("" : "+v"(tid));
  const int w = __builtin_amdgcn_readfirstlane(tid >> 6), lane = tid & 63, r = lane & 31, h = lane >> 5;
  const int sub = w >> 1, qhalf = w & 1;
  const int seq_start = seq == 0 ? 0 : L_PROMPT + (seq - 1) * 8192;
  const int L = seq == 0 ? L_PROMPT : 8192;
  const int q0 = seq_start + qt * 128 + qhalf * 64;
  const u32* misc = (const u32*)(p.ws + WS_MISC);
  const float* miscf = (const float*)misc;
  constexpr bool GQA = (NKS == 4);
  const int hd = GQA ? (2 * slot + sub) : (slot - 2);
  u16* Qb; const u16* Kb; const u16* VT; int kstride, ks0, kslot;
  if (GQA) { Qb = (u16*)(p.out + DO_BQ) + hd * 64; Kb = (const u16*)(p.out + DO_BK) + slot * 64; kstride = 128;
             VT = (const u16*)(p.out + DO_BVT) + (size_t)(slot * 64) * T_TOK; ks0 = 0; kslot = slot; }
  else { Qb = (u16*)(p.out + DO_CQ) + hd * 64 + 32 * sub; Kb = (const u16*)(p.out + DO_CK) + hd * 64; kstride = 256;
         VT = (const u16*)(p.ws + WS_CVT) + (size_t)(hd * 64) * T_TOK; ks0 = 2 * sub; kslot = 2 + hd * 2 + sub; }
  const float kmax = sqrtf(__uint_as_float(misc[layer * 50 + seq * 10 + kslot]));

  bf16x8 qf[2][NKS]; float ncb[2], lsum[2];
  f32x16 O[2][2];
#pragma unroll
  for (int qb = 0; qb < 2; ++qb) {
    float ss = 0.f;
#pragma unroll
    for (int ks = 0; ks < NKS; ++ks) {
      u32x4 v = *(const u32x4*)(Qb + (size_t)(q0 + 32 * qb + r) * 256 + 16 * ks + 8 * h);
      qf[qb][ks] = __builtin_bit_cast(bf16x8, v);
#pragma unroll
      for (int i = 0; i < 4; ++i) { float a = bflo(v[i]), b = bfhi(v[i]); ss += a * a + b * b; }
    }
    ss += xhalf(ss);
    ncb[qb] = -sqrtf(ss) * kmax; lsum[qb] = 0.f;
#pragma unroll
    for (int eb = 0; eb < 2; ++eb)
#pragma unroll
      for (int i = 0; i < 16; ++i) O[qb][eb][i] = 0.f;
  }

  auto stage = [&](int kt) {
    const int k0 = seq_start + kt * 128;
    char* base = smem + (kt & 1) * 32768;
#pragma unroll 1
    for (int i = 0; i < 4; ++i) {
      int c = tid + 256 * i; int row = c >> 3, lc = (c & 7) ^ ((row >> 1) & 7);
      __builtin_amdgcn_global_load_lds((const unsigned*)(Kb + (size_t)(k0 + row) * kstride + lc * 8), (unsigned*)(base + c * 16), 16, 0, 0);
      int sub = c >> 9, er = (c & 511) >> 3;
      __builtin_amdgcn_global_load_lds((const unsigned*)(VT + (size_t)er * T_TOK + k0 + sub * 64 + lc * 8), (unsigned*)(base + 16384 + c * 16), 16, 0, 0);
    }
  };
  const int nkt = L >> 7;
  const bool fast = wave_max(fmaxf(-ncb[0], -ncb[1])) < 60.f;
  auto mainloop = [&](auto SUBT) {
    constexpr bool SUB = decltype(SUBT)::value;
    for (int kt = 0; kt < nkt; ++kt) {
      asm volatile("s_waitcnt vmcnt(0)" ::: "memory");
      __syncthreads();
      if (kt + 1 < nkt) stage(kt + 1);
#pragma unroll 1
      for (int kh = 0; kh < 2; ++kh) {
      const u16* sK = (const u16*)(smem + (kt & 1) * 32768 + kh * 8192);
      const u16* sV = (const u16*)(smem + (kt & 1) * 32768 + 16384 + kh * 8192);
      auto kb_body = [&](int kb) {
        bf16x8 kf[NKS];
#pragma unroll
        for (int ks = 0; ks < NKS; ++ks) kf[ks] = *(const bf16x8*)(sK + swz(32 * kb + r, 2 * (ks0 + ks) + h));
        bf16x8 pk[2][2];
#pragma unroll
        for (int qb = 0; qb < 2; ++qb) {
          f32x16 st;
#pragma unroll
          for (int i = 0; i < 16; ++i) st[i] = SUB ? ncb[qb] : 0.f;
#pragma unroll
          for (int ks = 0; ks < NKS; ++ks) st = MFMA32(kf[ks], qf[qb][ks], st);
          float ls = 0.f;
#pragma unroll
          for (int i = 0; i < 16; ++i) { float e = __builtin_amdgcn_exp2f(st[i]); st[i] = e; ls = fadd1(ls, e); }
          lsum[qb] += ls;
          pk[qb][0] = pack8(st, 0); pk[qb][1] = pack8(st, 1);
        }
#pragma unroll
        for (int eb = 0; eb < 2; ++eb)
#pragma unroll
          for (int s2 = 0; s2 < 2; ++s2) {
            bf16x8 vf = *(const bf16x8*)(sV + swz(32 * eb + r, 4 * kb + 2 * s2 + h));
#pragma unroll
            for (int qb = 0; qb < 2; ++qb) O[qb][eb] = MFMA32(vf, pk[qb][s2], O[qb][eb]);
          }
      };
      if constexpr (SUB) {
#pragma unroll 1
        for (int kb = 0; kb < 2; ++kb) kb_body(kb);
      } else {
        kb_body(0); kb_body(1);
      }
      }
    }
  };
  __syncthreads();
  stage(0);
  if (fast) mainloop(std::false_type{}); else mainloop(std::true_type{});
  __syncthreads();
  if (GQA) {
    const u16* gate = (const u16*)(p.out + DO_GB) + hd * 64;
#pragma unroll
    for (int qb = 0; qb < 2; ++qb) {
      const float inv = 1.f / (lsum[qb] + xhalf(lsum[qb]));
      const size_t t = (size_t)(q0 + 32 * qb + r);
#pragma unroll
      for (int eb = 0; eb < 2; ++eb)
#pragma unroll
        for (int g = 0; g < 4; ++g) {
          int e = 32 * eb + 8 * g + 4 * h;
          u32x2 gt = *(const u32x2*)(gate + t * 256 + e);
          u32x2 o = {pack2bf(O[qb][eb][4 * g] * inv * bflo(gt[0]), O[qb][eb][4 * g + 1] * inv * bfhi(gt[0])),
                     pack2bf(O[qb][eb][4 * g + 2] * inv * bflo(gt[1]), O[qb][eb][4 * g + 3] * inv * bfhi(gt[1]))};
          if (wr) *(u32x2*)(Qb + t * 256 + e) = o;
        }
    }
  } else {
    float* xch = (float*)smem;
    const float lam = miscf[104 + layer];
    const float post = 1.f - (0.8f - 0.6f * __expf(-0.3f * (float)layer));
    const u16* gate = (const u16*)(p.out + DO_GC) + hd * 64;
    u16* outb = (u16*)(p.out + DO_CQ) + hd * 64;
    const float* dnw = p.diff_norm_w + layer * 64;
#pragma unroll
    for (int qb = 0; qb < 2; ++qb) {
      const float inv = 1.f / (lsum[qb] + xhalf(lsum[qb]));
      if (sub == 1) {
#pragma unroll
        for (int eb = 0; eb < 2; ++eb)
#pragma unroll
          for (int i = 0; i < 16; ++i) xch[(qhalf * 32 + eb * 16 + i) * 64 + lane] = O[qb][eb][i] * inv;
      }
      __syncthreads();
      if (sub == 0) {
        float ss = 0.f;
#pragma unroll
        for (int eb = 0; eb < 2; ++eb)
#pragma unroll
          for (int i = 0; i < 16; ++i) {
            float v = O[qb][eb][i] * inv - lam * xch[(qhalf * 32 + eb * 16 + i) * 64 + lane];
            O[qb][eb][i] = v; ss += v * v;
          }
        ss += xhalf(ss);
        const float rn = rsqrtf(ss * (1.f / 64.f) + EPS) * post;
        const size_t t = (size_t)(q0 + 32 * qb + r);
#pragma unroll
        for (int eb = 0; eb < 2; ++eb)
#pragma unroll
          for (int g = 0; g < 4; ++g) {
            int e = 32 * eb + 8 * g + 4 * h;
            u32x2 gt = *(const u32x2*)(gate + t * 256 + e);
            float4 nw = *(const float4*)(dnw + e);
            u32x2 o = {pack2bf(O[qb][eb][4 * g] * rn * nw.x * bflo(gt[0]), O[qb][eb][4 * g + 1] * rn * nw.y * bfhi(gt[0])),
                       pack2bf(O[qb][eb][4 * g + 2] * rn * nw.z * bflo(gt[1]), O[qb][eb][4 * g + 3] * rn * nw.w * bfhi(gt[1]))};
            if (wr) *(u32x2*)(outb + t * 256 + e) = o;
          }
      }
      __syncthreads();
    }
  }
}

template <int NKS>
DI void attn_loop(const Params& p, int layer, char* smem, bool wr = true) {
  constexpr int NSLOT = NKS == 4 ? 2 : 4, SLOT0 = NKS == 4 ? 0 : 2;
  u32* ctr = (u32*)(p.ws + WS_MISC) + (wr ? 100 : MISC_HCNT + 90) + layer * 2 + (NKS == 4 ? 0 : 1);
  int* s_tile = (int*)(smem + SMEM_BYTES - 16);
  for (;;) {
    __syncthreads();
    if (tidx(p) == 0) *s_tile = (int)atomicAdd(ctr, 1u);
    __syncthreads();
    const int idx = __builtin_amdgcn_readfirstlane(*s_tile);
    if (idx >= NSLOT * 384) break;
    int seq, slot, qt;
    if (idx < NSLOT * 128) { seq = 0; slot = idx >> 7; qt = idx & 127; }
    else { int i2 = idx - NSLOT * 128; seq = 1 + i2 / (NSLOT * 64); int rem = i2 % (NSLOT * 64); slot = rem >> 6; qt = rem & 63; }
    attn_tile<NKS>(p, layer, seq, SLOT0 + slot, qt, smem, wr);
  }
}

DI void mixer_phase(const Params& p, int layer, char* smem) {
  for (int u = blockIdx.x; u < H_UNITS; u += gridDim.x) hgrn_unit<1>(p, layer, u, smem);
  for (int u = blockIdx.x; u < H_UNITS; u += gridDim.x) hgrn_unit<2>(p, layer, u, smem);
#ifdef PROBE_DUP_ATTN
  if (p.dry) { attn_loop<2>(p, layer, smem, false); attn_loop<4>(p, layer, smem, false); }
#endif
  attn_loop<4>(p, layer, smem);
  attn_loop<2>(p, layer, smem);
}

template <int PH>
DI void run_phase(const Params& p, char* smem) {
  if (PH == 0) { phase0(p, smem); return; }
  constexpr int layer = (PH - 1) / 5, s = (PH - 1) % 5;
  if (s == 0) { gemm_phase<true>(p, layer, smem);
#ifdef PROBE_DUP_GIN
    __syncthreads(); gemm_phase<true>(p, layer, smem);
#endif
  }
  else if (s == 1) mixer_phase(p, layer, smem);
  else if (s == 2) hgrn_finalize(p, layer);
  else if (s == 3) { gemm_phase<false>(p, layer, smem);
#ifdef PROBE_DUP_GOUT
    __syncthreads(); gemm_phase<false>(p, layer, smem);
#endif
  }
  else rowprep(p, layer == 0 ? 1 : 2);
}

DI void grid_barrier(const Params& p, unsigned k) {
  __syncthreads();
  if (tidx(p) == 0) {
    u32* bar = (u32*)(p.ws + WS_MISC) + MISC_BAR2;
    const unsigned g = blockIdx.x & 7u, gsize = gridDim.x >> 3;
    __threadfence();
    const unsigned t = __hip_atomic_fetch_add(bar + g * 64, 1u, __ATOMIC_RELAXED, __HIP_MEMORY_SCOPE_AGENT);
    if (t + 1 == k * gsize) {
      __hip_atomic_fetch_add(bar + 1024, 1u, __ATOMIC_RELAXED, __HIP_MEMORY_SCOPE_AGENT);
      while (__hip_atomic_load(bar + 1024, __ATOMIC_RELAXED, __HIP_MEMORY_SCOPE_AGENT) < 8u * k) __builtin_amdgcn_s_sleep(2);
      __hip_atomic_store(bar + 512 + g * 64, k, __ATOMIC_RELAXED, __HIP_MEMORY_SCOPE_AGENT);
    } else {
      while (__hip_atomic_load(bar + 512 + g * 64, __ATOMIC_RELAXED, __HIP_MEMORY_SCOPE_AGENT) < k) __builtin_amdgcn_s_sleep(2);
    }
    __threadfence();
  }
  __syncthreads();
}

#ifndef MULTI_LAUNCH
__global__ void __launch_bounds__(256, 2) hymba_mega(Params p0) {
  __shared__ __attribute__((aligned(16))) char smem[SMEM_BYTES];
  Params p = p0;
  p.wid = __builtin_amdgcn_readfirstlane(threadIdx.x >> 6);
  const unsigned nb = gridDim.x;
  run_phase<0>(p, smem); cg::this_grid().sync();
  run_phase<1>(p, smem); grid_barrier(p, 1);
  run_phase<2>(p, smem); grid_barrier(p, 2);
  run_phase<3>(p, smem); grid_barrier(p, 3);
  run_phase<4>(p, smem); grid_barrier(p, 4);
  run_phase<5>(p, smem); grid_barrier(p, 5);
  run_phase<6>(p, smem); grid_barrier(p, 6);
  run_phase<7>(p, smem); grid_barrier(p, 7);
  run_phase<8>(p, smem); grid_barrier(p, 8);
  run_phase<9>(p, smem); grid_barrier(p, 9);
  run_phase<10>(p, smem);
}
#else
template <int PH>
__global__ void __launch_bounds__(256, 2) hymba_phase(Params p0) {
  __shared__ __attribute__((aligned(16))) char smem[SMEM_BYTES];
  Params p = p0;
  p.wid = __builtin_amdgcn_readfirstlane(threadIdx.x >> 6);
  run_phase<PH>(p, smem);
}
#endif

extern "C" void kernel_launch(void* const* d_in, const int* in_sizes, int n_in, void* d_out, int out_size,
                              void* d_ws, size_t ws_size, hipStream_t stream) {
  static int grid_blocks = 0;
  if (!grid_blocks) {
    int dev = 0, cus = 0, per_cu = 2;
    (void)hipGetDevice(&dev);
    (void)hipDeviceGetAttribute(&cus, hipDeviceAttributeMultiprocessorCount, dev);
#ifndef MULTI_LAUNCH
    (void)hipOccupancyMaxActiveBlocksPerMultiprocessor(&per_cu, hymba_mega, 256, 0);
#endif
    if (per_cu > 2) per_cu = 2;
    if (per_cu < 1) per_cu = 1;
    grid_blocks = cus * per_cu;
  }
  Params p;
  memset(&p, 0, sizeof(p));
  p.x_prompt = (const float*)d_in[0]; p.x_sample = (const float*)d_in[1]; p.pre_norm_w = (const float*)d_in[2];
  p.w_in = (const float*)d_in[3]; p.hgrn_lb = (const float*)d_in[4]; p.hgrn_norm_w = (const float*)d_in[5];
  p.gqa_q_norm_w = (const float*)d_in[6]; p.gqa_k_norm_w = (const float*)d_in[7]; p.diff_lambda = (const float*)d_in[8];
  p.diff_norm_w = (const float*)d_in[9]; p.w_out = (const float*)d_in[10]; p.post_norm_w = (const float*)d_in[11];
  p.out = (char*)d_out; p.ws = (char*)d_ws;
#ifdef PROBE_DUP_ATTN
  p.dry = 1;
#endif
#ifndef MULTI_LAUNCH
  void* args[] = {&p};
  hipError_t e = hipLaunchCooperativeKernel((void*)hymba_mega, dim3(grid_blocks), dim3(256), args, 0, stream);
  if (e != hipSuccess) fprintf(stderr, "cooperative launch failed: %s (grid %d)\n", hipGetErrorString(e), grid_blocks);
#else
  dim3 g(grid_blocks), b(256);
  hymba_phase<0><<<g, b, 0, stream>>>(p); hymba_phase<1><<<g, b, 0, stream>>>(p); hymba_phase<2><<<g, b, 0, stream>>>(p);
  hymba_phase<3><<<g, b, 0, stream>>>(p); hymba_phase<4><<<g, b, 0, stream>>>(p); hymba_phase<5><<<g, b, 0, stream>>>(p);
  hymba_phase<6><<<g, b, 0, stream>>>(p); hymba_phase<7><<<g, b, 0, stream>>>(p); hymba_phase<8><<<g, b, 0, stream>>>(p);
  hymba_phase<9><<<g, b, 0, stream>>>(p); hymba_phase<10><<<g, b, 0, stream>>>(p);
#endif
}
```

```cpp
#include <hip/hip_runtime.h>
#include <hip/hip_cooperative_groups.h>
#include <cstdio>
#include <cmath>
#include <cstring>
#include <type_traits>
namespace cg = cooperative_groups;

#define DI __device__ __forceinline__
typedef unsigned short u16;
typedef unsigned int u32;
using bf16x8 = __attribute__((ext_vector_type(8))) short;
using s16x4  = __attribute__((ext_vector_type(4))) short;
using f32x16 = __attribute__((ext_vector_type(16))) float;
using f32x2  = __attribute__((ext_vector_type(2))) float;
using f32x4m = __attribute__((ext_vector_type(4))) float;
using bf2_t  = __attribute__((ext_vector_type(2))) __bf16;
using u32x4  = __attribute__((ext_vector_type(4))) unsigned;
using u32x2  = __attribute__((ext_vector_type(2))) unsigned;
#define MFMA32(a, b, c) __builtin_amdgcn_mfma_f32_32x32x16_bf16((a), (b), (c), 0, 0, 0)

constexpr int T_TOK = 49152;
constexpr int L_PROMPT = 16384;
constexpr int DM = 1024;
constexpr int NCOL = 4352;
constexpr float EPS = 1e-6f;
constexpr float LOG2E = 1.4426950408889634f;
constexpr size_t MiB = 1u << 20;

constexpr size_t WS_HQ = 0;
constexpr size_t WS_GF = 48 * MiB;
constexpr size_t WS_GB = 96 * MiB;
constexpr size_t WS_HV = 144 * MiB;
constexpr size_t WS_Y = 0;
constexpr size_t WS_CVT = 192 * MiB;
constexpr size_t WS_XB = 216 * MiB;
constexpr size_t WS_OF = WS_XB;
constexpr size_t WS_OB = WS_XB + 48 * MiB;
constexpr size_t WS_R0 = 312 * MiB;
constexpr size_t WS_WIN = 408 * MiB;
constexpr size_t WS_WOUT = 425 * MiB;
constexpr size_t WS_TAB = 429 * MiB;
constexpr size_t WS_RSTD = 431 * MiB;
constexpr size_t WS_MISC = 431 * MiB + 256 * 1024;
constexpr size_t WS_HF = 432 * MiB;
constexpr size_t WS_HD = 456 * MiB;
constexpr int MISC_HCNT = 1200;
constexpr int MISC_BAR = 1400;
constexpr int MISC_BAR2 = 4096;
constexpr int MISC_GCTR = 1440;
constexpr size_t DO_BQ = 0;
constexpr size_t DO_CQ = 24 * MiB;
constexpr size_t DO_GA = 48 * MiB;
constexpr size_t DO_GB = 96 * MiB;
constexpr size_t DO_GC = 120 * MiB;
constexpr size_t DO_BK = 144 * MiB;
constexpr size_t DO_BVT = 156 * MiB;
constexpr size_t DO_CK = 168 * MiB;

constexpr float QS_GQA = 0.125f * LOG2E;
constexpr float QS_DIFF = 0.17677669529663687f * LOG2E;

struct Params {
  const float* x_prompt; const float* x_sample; const float* pre_norm_w; const float* w_in;
  const float* hgrn_lb; const float* hgrn_norm_w; const float* gqa_q_norm_w; const float* gqa_k_norm_w;
  const float* diff_lambda; const float* diff_norm_w; const float* w_out; const float* post_norm_w;
  char* out; char* ws;
  int dry; int wid;
};
DI int tidx(const Params& p) {
  int l = (int)__builtin_amdgcn_mbcnt_hi(~0u, __builtin_amdgcn_mbcnt_lo(~0u, 0u));
  asm volatile("" : "+v"(l));
  return p.wid * 64 + l;
}

DI u32 pack2bf(float lo, float hi) { f32x2 v = {lo, hi}; return __builtin_bit_cast(u32, __builtin_convertvector(v, bf2_t)); }
DI u16 f2bf(float x) { return (u16)(pack2bf(x, 0.f) & 0xffffu); }
DI float bf2f(u16 b) { return __uint_as_float(((u32)b) << 16); }
DI float bflo(u32 w) { return __uint_as_float(w << 16); }
DI float bfhi(u32 w) { return __uint_as_float(w & 0xffff0000u); }
DI u16 f2h(float x) { _Float16 h = (_Float16)x; return __builtin_bit_cast(u16, h); }
DI float h2f(u16 b) { return (float)__builtin_bit_cast(_Float16, b); }
DI unsigned xcc_id() { return (unsigned)__builtin_amdgcn_s_getreg((3 << 11) | 20) & 0xFu; }
DI int crow(int i, int h) { return (i & 3) + 8 * (i >> 2) + 4 * h; }
DI bf16x8 pack8(const f32x16& x, int s) {
  u32x4 p;
  p[0] = pack2bf(x[8 * s + 0], x[8 * s + 1]); p[1] = pack2bf(x[8 * s + 2], x[8 * s + 3]);
  p[2] = pack2bf(x[8 * s + 4], x[8 * s + 5]); p[3] = pack2bf(x[8 * s + 6], x[8 * s + 7]);
  return __builtin_bit_cast(bf16x8, p);
}
DI bf16x8 cat44(s16x4 lo, s16x4 hi) { return __builtin_shufflevector(lo, hi, 0, 1, 2, 3, 4, 5, 6, 7); }
DI float fadd1(float a, float b) { float r; asm("v_add_f32 %0, %1, %2" : "=v"(r) : "v"(a), "v"(b)); return r; }
DI float xhalf(float v) { return __shfl_xor(v, 32); }
DI float wave_sum(float v) { for (int o = 32; o; o >>= 1) v += __shfl_xor(v, o); return v; }
DI float wave_max(float v) { for (int o = 32; o; o >>= 1) v = fmaxf(v, __shfl_xor(v, o)); return v; }
DI float sigm(float x) { return __builtin_amdgcn_rcpf(1.f + __builtin_amdgcn_exp2f(-LOG2E * x)); }
DI int seq_of(int t) { return t < L_PROMPT ? 0 : 1 + ((t - L_PROMPT) >> 13); }
DI int pos_of(int t) { return t < L_PROMPT ? t : (t & 8191); }

DI void transpose_unit(const Params& p, int u, char* smem) {
  u16* tile = (u16*)smem;
  const int tid = tidx(p);
  const float* src; u16* dst; const float* rw = nullptr; int N, kt, nt;
  if (u < 2176) { int l = u / 1088, r = u % 1088; kt = r / 68; nt = r % 68; N = NCOL;
    src = p.w_in + (size_t)l * DM * NCOL; dst = (u16*)(p.ws + WS_WIN) + (size_t)l * NCOL * DM; rw = p.pre_norm_w + l * DM; }
  else { int v = u - 2176; int l = v / 256, r = v % 256; kt = r / 16; nt = r % 16; N = DM;
    src = p.w_out + (size_t)l * DM * DM; dst = (u16*)(p.ws + WS_WOUT) + (size_t)l * DM * DM; }
  const int c4 = (tid & 15) * 4, r0 = tid >> 4;
  __syncthreads();
#pragma unroll
  for (int i = 0; i < 4; ++i) {
    int r = r0 + 16 * i; int k = kt * 64 + r;
    float4 v = *(const float4*)(src + (size_t)k * N + nt * 64 + c4);
    float w = rw ? rw[k] : 1.f;
    tile[(c4 + 0) * 72 + r] = f2bf(v.x * w); tile[(c4 + 1) * 72 + r] = f2bf(v.y * w);
    tile[(c4 + 2) * 72 + r] = f2bf(v.z * w); tile[(c4 + 3) * 72 + r] = f2bf(v.w * w);
  }
  __syncthreads();
#pragma unroll
  for (int i = 0; i < 2; ++i) {
    int n = (tid >> 3) + 32 * i, ch = tid & 7;
    u32x4 v = *(const u32x4*)(tile + n * 72 + ch * 8);
    *(u32x4*)(dst + (size_t)(nt * 64 + n) * DM + kt * 64 + ch * 8) = v;
  }
}

DI void sincos_d(double x, float& c, float& s) {
  const double x2 = x * x;
  double ts = 0.0, tc = 0.0;
#pragma unroll
  for (int n = 14; n >= 1; --n) {
    const double cs_ = -1.0 / (double)((2 * n) * (2 * n + 1));
    const double cc_ = -1.0 / (double)((2 * n - 1) * (2 * n));
    ts = (1.0 + ts) * (x2 * cs_);
    tc = (1.0 + tc) * (x2 * cc_);
  }
  c = (float)(1.0 + tc); s = (float)(x * (1.0 + ts));
}

DI void table_unit(const Params& p, int u) {
  int idx = u * 256 + tidx(p);
  int i = idx >> 14, pos = idx & 16383;
  const int i4 = i & 3, i16 = i >> 2;
  double inv = i4 == 0 ? 1.0 : (i4 == 1 ? 0.5623413251903491 : (i4 == 2 ? 0.31622776601683794 : 0.1778279410038923));
  inv *= i16 == 0 ? 1.0 : (i16 == 1 ? 0.1 : (i16 == 2 ? 0.01 : 0.001));
  double ang = (double)pos * inv;
  double rev = ang * 0.15915494309189535;
  rev -= rint(rev);
  float c, s; sincos_d(rev * 6.283185307179586, c, s);
  ((float2*)(p.ws + WS_TAB))[idx] = make_float2(c, s);
}

using f32x4v = __attribute__((ext_vector_type(4))) float;
DI float4 ntload4(const float* ptr) { f32x4v v = __builtin_nontemporal_load((const f32x4v*)ptr); return make_float4(v[0], v[1], v[2], v[3]); }
DI const float* x_row(const Params& p, int row) {
  return row < L_PROMPT ? p.x_prompt + (size_t)row * DM : p.x_sample + (size_t)(row - L_PROMPT) * DM;
}

DI void rowprep(const Params& p, int mode) {
  const int wave = tidx(p) >> 6, lane = tidx(p) & 63;
  const u16* yb = (const u16*)(p.ws + WS_Y);
  u16* r0b = (u16*)(p.ws + WS_R0);
  u16* xb = (u16*)(p.ws + WS_XB);
  float* rstd = (float*)(p.ws + WS_RSTD);
  const float* pw = p.post_norm_w + (mode == 2 ? DM : 0);
  for (int row = blockIdx.x * 4 + wave; row < T_TOK; row += gridDim.x * 4) {
    const float* x0 = x_row(p, row);
    float4 xv[4];
#pragma unroll
    for (int i = 0; i < 4; ++i) xv[i] = ntload4(x0 + lane * 4 + 256 * i);
    if (mode >= 1) {
      float4 yv[4]; float ss = 0.f;
#pragma unroll
      for (int i = 0; i < 4; ++i) {
        { u32x2 yp = *(const u32x2*)(yb + (size_t)row * DM + lane * 4 + 256 * i);
          yv[i] = make_float4(bflo(yp[0]), bfhi(yp[0]), bflo(yp[1]), bfhi(yp[1])); }
        ss += yv[i].x * yv[i].x + yv[i].y * yv[i].y + yv[i].z * yv[i].z + yv[i].w * yv[i].w;
      }
      ss = wave_sum(ss);
      float rs = rsqrtf(ss * (1.f / DM) + EPS);
#pragma unroll
      for (int i = 0; i < 4; ++i) {
        float4 w = *(const float4*)(pw + lane * 4 + 256 * i);
        float4 r = make_float4(yv[i].x * rs * w.x, yv[i].y * rs * w.y, yv[i].z * rs * w.z, yv[i].w * rs * w.w);
        size_t off = (size_t)row * DM + lane * 4 + 256 * i;
        if (mode == 1) {
          u16 h0 = f2h(r.x), h1 = f2h(r.y), h2 = f2h(r.z), h3 = f2h(r.w);
          u32x2 pk = {(u32)h0 | ((u32)h1 << 16), (u32)h2 | ((u32)h3 << 16)};
          __builtin_nontemporal_store(pk, (u32x2*)(r0b + off));
          xv[i].x += h2f(h0); xv[i].y += h2f(h1); xv[i].z += h2f(h2); xv[i].w += h2f(h3);
        } else {
          u32x2 pk = *(const u32x2*)(r0b + off);
          float4 o;
          o.x = (xv[i].x + h2f((u16)(pk[0] & 0xffff))) + r.x;
          o.y = (xv[i].y + h2f((u16)(pk[0] >> 16))) + r.y;
          o.z = (xv[i].z + h2f((u16)(pk[1] & 0xffff))) + r.z;
          o.w = (xv[i].w + h2f((u16)(pk[1] >> 16))) + r.w;
          { f32x4v ov = {o.x, o.y, o.z, o.w}; __builtin_nontemporal_store(ov, (f32x4v*)((float*)p.out + off)); }
        }
      }
    }
    if (mode <= 1) {
      float ss = 0.f;
#pragma unroll
      for (int i = 0; i < 4; ++i) {
        ss += xv[i].x * xv[i].x + xv[i].y * xv[i].y + xv[i].z * xv[i].z + xv[i].w * xv[i].w;
        u32x2 pk = {pack2bf(xv[i].x, xv[i].y), pack2bf(xv[i].z, xv[i].w)};
        *(u32x2*)(xb + (size_t)row * DM + lane * 4 + 256 * i) = pk;
      }
      ss = wave_sum(ss);
      if (lane == 0) rstd[row] = rsqrtf(ss * (1.f / DM) + EPS);
    }
  }
}

DI void phase0(const Params& p, char* smem) {
  const int nb = gridDim.x, b = blockIdx.x;
  for (int u = b; u < 2688; u += nb) transpose_unit(p, u, smem);
  for (int u = b; u < 1024; u += nb) table_unit(p, u);
  rowprep(p, 0);
  if (b == 0) {
    u32* misc = (u32*)(p.ws + WS_MISC);
    float* miscf = (float*)misc;
    const int tid = tidx(p);
    if (tid < 104) misc[tid] = 0u;
    if (tid < 96) misc[MISC_HCNT + tid] = 0u;
    for (int i = tid; i < 1100; i += 256) misc[MISC_BAR2 + i] = 0u;
    if (tid < 32) misc[MISC_GCTR + tid] = 0u;
    if (tid < 2) {
      const float* lp = p.diff_lambda + tid * 128;
      float a = 0.f, c = 0.f;
      for (int i = 0; i < 32; ++i) { a += lp[i] * lp[32 + i]; c += lp[64 + i] * lp[96 + i]; }
      float lam_init = 0.8f - 0.6f * expf(-0.3f * (float)tid);
      miscf[104 + tid] = expf(a) - expf(c) + lam_init;
    }
    for (int i = tid; i < 1024; i += 256) {
      float a0 = p.hgrn_lb[i], a1 = p.hgrn_lb[1024 + i];
      miscf[128 + i] = 1.f / (1.f + expf(a0 - a1));
    }
  }
}

constexpr int HS = 136;
constexpr int VS = 40;
constexpr int H_QM = 0, H_KM = 8704, H_QB = 17408, H_KLT = 26112, H_VT = 36352, H_DEC = 46592;
constexpr int H_RAW = 47104;
constexpr int SMEM_BYTES = 47104 + 32768 + 16;
constexpr int GS = 72;
constexpr int CS = 136;

enum { K_SILU = 0, K_COPY, K_G, K_QN, K_KN, K_VT, K_CQ, K_CK };

struct TileDesc { int kind; u16* dst; int stride; int col; int aux; };

DI TileDesc tile_desc(const Params& p, int nt) {
  TileDesc d; d.aux = 0;
  char* ws = p.ws; char* o = p.out;
  if (nt < 4)       { d.kind = K_SILU; d.dst = (u16*)(ws + WS_HQ); d.stride = 512; d.col = nt * 128; }
  else if (nt < 8)  { d.kind = K_G;    d.dst = (u16*)(ws + WS_GF); d.stride = 512; d.col = (nt - 4) * 128; d.aux = 0; }
  else if (nt < 12) { d.kind = K_G;    d.dst = (u16*)(ws + WS_GB); d.stride = 512; d.col = (nt - 8) * 128; d.aux = 1; }
  else if (nt < 16) { d.kind = K_COPY; d.dst = (u16*)(ws + WS_HV); d.stride = 512; d.col = (nt - 12) * 128; }
  else if (nt < 20) { d.kind = K_SILU; d.dst = (u16*)(o + DO_GA);  d.stride = 512; d.col = (nt - 16) * 128; }
  else if (nt < 22) { d.kind = K_QN;   d.dst = (u16*)(o + DO_BQ);  d.stride = 256; d.col = (nt - 20) * 128; }
  else if (nt < 23) { d.kind = K_KN;   d.dst = (u16*)(o + DO_BK);  d.stride = 128; d.col = 0; }
  else if (nt < 24) { d.kind = K_VT;   d.dst = (u16*)(o + DO_BVT); d.stride = T_TOK; d.col = 0; }
  else if (nt < 26) { d.kind = K_SILU; d.dst = (u16*)(o + DO_GB);  d.stride = 256; d.col = (nt - 24) * 128; }
  else if (nt < 28) { d.kind = K_CQ;   d.dst = (u16*)(o + DO_CQ);  d.stride = 256; d.col = (nt - 26) * 128; }
  else if (nt < 30) { d.kind = K_CK;   d.dst = (u16*)(o + DO_CK);  d.stride = 256; d.col = (nt - 28) * 128; d.aux = (nt - 28); }
  else if (nt < 32) { d.kind = K_VT;   d.dst = (u16*)(ws + WS_CVT); d.stride = T_TOK; d.col = (nt - 30) * 128; }
  else              { d.kind = K_SILU; d.dst = (u16*)(o + DO_GC);  d.stride = 256; d.col = (nt - 32) * 128; }
  return d;
}

DI void rope_pairs(f32x16& x, const float2* tab, int pos, int h, float scale) {
#pragma unroll
  for (int i = 0; i < 8; ++i) {
    int idx = crow(i, h);
    float2 cs = tab[idx * 16384 + pos];
    float a = x[i], b = x[i + 8];
    x[i] = (a * cs.x - b * cs.y) * scale;
    x[i + 8] = (b * cs.x + a * cs.y) * scale;
  }
}

DI void rope32(float* x, const float2* tab, int pos, float scale) {
#pragma unroll
  for (int j = 0; j < 16; ++j) {
    float2 cs = tab[j * 16384 + pos];
    float a = x[j], b = x[j + 16];
    x[j] = (a * cs.x - b * cs.y) * scale;
    x[j + 16] = (b * cs.x + a * cs.y) * scale;
  }
}
DI void qk_post(const Params& p, int layer, int nt, int t0, int tid, char* smem) {
  const float2* tab = (const float2*)(p.ws + WS_TAB);
  u32* misc = (u32*)(p.ws + WS_MISC);
  const int tl = tid & 127, hh = __builtin_amdgcn_readfirstlane(tid >> 7), lane = tid & 63;
  const int pos = pos_of(t0 + tl), seq = seq_of(t0);
#pragma unroll 1
  for (int hf = 0; hf < 2; ++hf) {
    const TileDesc d = tile_desc(p, nt * 2 + hf);
    if (d.kind != K_QN && d.kind != K_KN && d.kind != K_CQ && d.kind != K_CK) continue;
    u16* row = (u16*)(smem + hf * 34816) + tl * CS + hh * 64;
    float x[64];
#pragma unroll
    for (int c = 0; c < 8; ++c) {
      u32x4 v = *(const u32x4*)(row + c * 8);
#pragma unroll
      for (int i = 0; i < 4; ++i) { x[c * 8 + 2 * i] = bflo(v[i]); x[c * 8 + 2 * i + 1] = bfhi(v[i]); }
    }
    if (d.kind == K_QN || d.kind == K_KN) {
      const float* nw = (d.kind == K_QN ? p.gqa_q_norm_w : p.gqa_k_norm_w) + layer * 64;
      float ss = 0.f;
#pragma unroll
      for (int j = 0; j < 64; ++j) ss += x[j] * x[j];
      const float rn = rsqrtf(ss * (1.f / 64.f) + EPS);
      float s2 = 0.f;
#pragma unroll
      for (int j = 0; j < 64; ++j) { x[j] *= rn * nw[j]; s2 += x[j] * x[j]; }
      const float sc = d.kind == K_QN ? QS_GQA : 1.f;
      rope32(x, tab, pos >> 6, sc);
      rope32(x + 32, tab, pos & 63, sc);
      if (d.kind == K_KN) {
        s2 = wave_max(s2);
        if (lane == 0) atomicMax(&misc[layer * 50 + seq * 10 + hh], __float_as_uint(s2 * 1.02f));
      }
    } else {
      const float sc = d.kind == K_CQ ? QS_DIFF : 1.f;
      if (d.kind == K_CK) {
#pragma unroll
        for (int m = 0; m < 2; ++m) {
          float s2 = 0.f;
#pragma unroll
          for (int j = 0; j < 32; ++j) s2 += x[m * 32 + j] * x[m * 32 + j];
          s2 = wave_max(s2);
          if (lane == 0) atomicMax(&misc[layer * 50 + seq * 10 + 2 + (d.aux * 2 + hh) * 2 + m], __float_as_uint(s2 * 1.02f));
        }
      }
      rope32(x, tab, pos, sc);
      rope32(x + 32, tab, pos, sc);
    }
#pragma unroll
    for (int c = 0; c < 8; ++c) {
      u32x4 v;
#pragma unroll
      for (int i = 0; i < 4; ++i) v[i] = pack2bf(x[c * 8 + 2 * i], x[c * 8 + 2 * i + 1]);
      *(u32x4*)(row + c * 8) = v;
    }
  }
  __syncthreads();
}

constexpr int G_STAGE = 24576;
DI int gswz(int row, int lc) { return row * 32 + ((lc ^ ((row >> 2) & 3)) << 3); }

template <bool IN_PROJ>
DI void gemm_tile(const Params& p, int layer, int nt, int tt, char* smem) {
  int tid = tidx(p);
  asm volatile("" : "+v"(tid));
  const int w = __builtin_amdgcn_readfirstlane(tid >> 6), lane = tid & 63, r = lane & 31, h = lane >> 5;
  const int wf = w >> 1, wt = w & 1;
  const int n0 = nt * 256, t0 = tt * 128;
  const u16* Wt = IN_PROJ ? (const u16*)(p.ws + WS_WIN) + (size_t)layer * NCOL * DM
                          : (const u16*)(p.ws + WS_WOUT) + (size_t)layer * DM * DM;
  const u16* xb = (const u16*)(p.ws + WS_XB);
  const u16* mixA = (const u16*)(p.ws + WS_OF);
  const u16* mixB = (const u16*)(p.out + DO_BQ);
  const u16* mixC = (const u16*)(p.out + DO_CQ);

  f32x16 acc[4][2];
#pragma unroll
  for (int a = 0; a < 4; ++a)
#pragma unroll
    for (int b = 0; b < 2; ++b)
#pragma unroll
      for (int i = 0; i < 16; ++i) acc[a][b][i] = 0.f;

  auto stage = [&](int kt) {
    const int k0 = kt * 32;
    char* base = smem + (kt % 3) * G_STAGE;
#pragma unroll
    for (int i = 0; i < 4; ++i) {
      int c = tid + 256 * i; int row = c >> 2, lc = (c & 3) ^ ((row >> 2) & 3);
      __builtin_amdgcn_global_load_lds((const unsigned*)(Wt + (size_t)(n0 + row) * DM + k0 + lc * 8), (unsigned*)(base + c * 16), 16, 0, 0);
    }
#pragma unroll
    for (int i = 0; i < 2; ++i) {
      int c = tid + 256 * i; int row = c >> 2, lc = (c & 3) ^ ((row >> 2) & 3);
      const u16* bp;
      if (IN_PROJ) bp = xb + (size_t)(t0 + row) * DM + k0 + lc * 8;
      else {
        if (k0 < 512) bp = mixA + (size_t)(t0 + row) * 512 + k0 + lc * 8;
        else if (k0 < 768) bp = mixB + (size_t)(t0 + row) * 256 + (k0 - 512) + lc * 8;
        else bp = mixC + (size_t)(t0 + row) * 256 + (k0 - 768) + lc * 8;
      }
      __builtin_amdgcn_global_load_lds((const unsigned*)bp, (unsigned*)(base + 16384 + c * 16), 16, 0, 0);
    }
  };
  asm volatile("s_waitcnt vmcnt(0)" ::: "memory");
  __syncthreads();
  stage(0); stage(1); stage(2);
  auto load_frags = [&](int kt, int ks, bf16x8 (&fa)[4], bf16x8 (&fb)[2]) {
    const u16* sA = (const u16*)(smem + (kt % 3) * G_STAGE);
    const u16* sB = sA + 8192;
#pragma unroll
    for (int fi = 0; fi < 4; ++fi) fa[fi] = *(const bf16x8*)(sA + gswz(wf * 128 + fi * 32 + r, ks * 2 + h));
#pragma unroll
    for (int ti = 0; ti < 2; ++ti) fb[ti] = *(const bf16x8*)(sB + gswz(wt * 64 + ti * 32 + r, ks * 2 + h));
  };
  auto mma = [&](const bf16x8 (&fa)[4], const bf16x8 (&fb)[2]) {
#pragma unroll
    for (int fi = 0; fi < 4; ++fi)
#pragma unroll
      for (int ti = 0; ti < 2; ++ti) acc[fi][ti] = MFMA32(fa[fi], fb[ti], acc[fi][ti]);
  };
  bf16x8 fa0[4], fb0[2], fa1[4], fb1[2];
  asm volatile("s_waitcnt vmcnt(12)" ::: "memory");
  __syncthreads();
  load_frags(0, 0, fa0, fb0);
  for (int kt = 0; kt < 32; ++kt) {
    load_frags(kt, 1, fa1, fb1);
    mma(fa0, fb0);
    if (kt + 1 < 32) {
      if (kt + 2 < 32) asm volatile("s_waitcnt vmcnt(6) lgkmcnt(0)" ::: "memory");
      else asm volatile("s_waitcnt vmcnt(0) lgkmcnt(0)" ::: "memory");
      __syncthreads();
      if (kt + 3 < 32) stage(kt + 3);
      load_frags(kt + 1, 0, fa0, fb0);
    }
    mma(fa1, fb1);
  }
  __syncthreads();

  if (!IN_PROJ) {
    u16* yb = (u16*)(p.ws + WS_Y);
    u16* sC = (u16*)(smem + wf * 34816);
#pragma unroll
    for (int fi = 0; fi < 4; ++fi)
#pragma unroll
      for (int ti = 0; ti < 2; ++ti)
#pragma unroll
        for (int g = 0; g < 4; ++g) {
          u32x2 pk = {pack2bf(acc[fi][ti][4 * g], acc[fi][ti][4 * g + 1]), pack2bf(acc[fi][ti][4 * g + 2], acc[fi][ti][4 * g + 3])};
          *(u32x2*)(sC + (wt * 64 + ti * 32 + r) * CS + fi * 32 + 8 * g + 4 * h) = pk;
        }
    __syncthreads();
#pragma unroll
    for (int hf = 0; hf < 2; ++hf) {
      const u16* sH = (const u16*)(smem + hf * 34816);
#pragma unroll
      for (int i = 0; i < 8; ++i) {
        int c = tid + 256 * i; int row = c >> 4, cc = c & 15;
        u32x4 v = *(const u32x4*)(sH + row * CS + cc * 8);
        *(u32x4*)(yb + (size_t)(t0 + row) * DM + n0 + hf * 128 + cc * 8) = v;
      }
    }
    return;
  }

  const TileDesc d = tile_desc(p, nt * 2 + wf);
  const float* rstd = (const float*)(p.ws + WS_RSTD);
  u32* misc = (u32*)(p.ws + WS_MISC);
  const float* miscf = (const float*)misc;
  u16* sC = (u16*)(smem + wf * 34816);
#pragma unroll
  for (int ti = 0; ti < 2; ++ti) {
    const int t = t0 + wt * 64 + ti * 32 + r;
    const float rs = rstd[t];
#pragma unroll
    for (int fi = 0; fi < 4; ++fi)
#pragma unroll
      for (int i = 0; i < 16; ++i) acc[fi][ti][i] *= rs;
    if (d.kind == K_SILU) {
#pragma unroll
      for (int fi = 0; fi < 4; ++fi)
#pragma unroll
        for (int i = 0; i < 16; ++i) { float x = acc[fi][ti][i]; acc[fi][ti][i] = x * sigm(x); }
    } else if (d.kind == K_G) {
#pragma unroll
      for (int fi = 0; fi < 4; ++fi)
#pragma unroll
        for (int g = 0; g < 4; ++g) {
          float4 lb4 = make_float4(0.f, 0.f, 0.f, 0.f);
          if (layer != 0) lb4 = *(const float4*)(miscf + 128 + d.aux * 512 + d.col + fi * 32 + 8 * g + 4 * h);
          acc[fi][ti][4 * g] = __logf(lb4.x + (1.f - lb4.x) * sigm(acc[fi][ti][4 * g]));
          acc[fi][ti][4 * g + 1] = __logf(lb4.y + (1.f - lb4.y) * sigm(acc[fi][ti][4 * g + 1]));
          acc[fi][ti][4 * g + 2] = __logf(lb4.z + (1.f - lb4.z) * sigm(acc[fi][ti][4 * g + 2]));
          acc[fi][ti][4 * g + 3] = __logf(lb4.w + (1.f - lb4.w) * sigm(acc[fi][ti][4 * g + 3]));
        }
    }
    if (d.kind == K_VT) {
      const int rp = (r & ~12) | ((r & 4) << 1) | ((r & 8) >> 1);
#pragma unroll
      for (int fi = 0; fi < 4; ++fi)
#pragma unroll
        for (int i = 0; i < 16; ++i)
          sC[(fi * 32 + crow(i, h)) * CS + wt * 64 + ti * 32 + rp] = f2bf(acc[fi][ti][i]);
    } else {
#pragma unroll
      for (int fi = 0; fi < 4; ++fi)
#pragma unroll
        for (int g = 0; g < 4; ++g) {
          u32x2 pk;
          if (d.kind == K_G) {
            pk[0] = (u32)f2h(acc[fi][ti][4 * g]) | ((u32)f2h(acc[fi][ti][4 * g + 1]) << 16);
            pk[1] = (u32)f2h(acc[fi][ti][4 * g + 2]) | ((u32)f2h(acc[fi][ti][4 * g + 3]) << 16);
          } else {
            pk[0] = pack2bf(acc[fi][ti][4 * g], acc[fi][ti][4 * g + 1]);
            pk[1] = pack2bf(acc[fi][ti][4 * g + 2], acc[fi][ti][4 * g + 3]);
          }
          *(u32x2*)(sC + (wt * 64 + ti * 32 + r) * CS + fi * 32 + 8 * g + 4 * h) = pk;
        }
    }
  }
  __syncthreads();
  if (nt == 10 || nt == 11 || nt == 13 || nt == 14) qk_post(p, layer, nt, t0, tid, smem);
#pragma unroll
  for (int hf = 0; hf < 2; ++hf) {
    const TileDesc dd = tile_desc(p, nt * 2 + hf);
    const u16* sH = (const u16*)(smem + hf * 34816);
#pragma unroll
    for (int i = 0; i < 8; ++i) {
      int c = tid + 256 * i; int row = c >> 4, cc = c & 15;
      u32x4 v = *(const u32x4*)(sH + row * CS + cc * 8);
      if (dd.kind == K_VT) *(u32x4*)(dd.dst + (size_t)(dd.col + row) * T_TOK + t0 + cc * 8) = v;
      else *(u32x4*)(dd.dst + (size_t)(t0 + row) * dd.stride + dd.col + cc * 8) = v;
    }
  }
}

template <bool IN_PROJ>
DI void gemm_phase(const Params& p, int layer, char* smem) {
  constexpr int NT = IN_PROJ ? 17 : 4;
  constexpr int PER_XCD = 48 * NT;
  u32* ctr = (u32*)(p.ws + WS_MISC) + MISC_GCTR + layer * 16 + (IN_PROJ ? 0 : 8);
  int* s_tile = (int*)(smem + SMEM_BYTES - 16);
  const int x0 = (int)xcc_id() & 7;
  for (int a = 0; a < 8; ++a) {
    const int xq = (x0 + a) & 7;
    for (;;) {
      __syncthreads();
      if (tidx(p) == 0) *s_tile = (int)atomicAdd(ctr + xq, 1u);
      __syncthreads();
      const int q = __builtin_amdgcn_readfirstlane(*s_tile);
      if (q >= PER_XCD) break;
      int grp = q / (8 * NT), rem = q % (8 * NT);
      int nt = rem >> 3; int ttl = grp * 8 + (rem & 7);
      int tt = ttl * 8 + xq;
      gemm_tile<IN_PROJ>(p, layer, nt, tt, smem);
    }
  }
}


constexpr int HSEG = 128;
constexpr int H_UNITS = 96;

template <int PASS>
DI void hgrn_unit(const Params& p, int layer, int unit, char* smem) {
  int seq, grp, seg, nseg, ubase;
  if (unit < 32) { seq = 0; grp = unit >> 2; seg = unit & 3; nseg = 4; ubase = unit & ~3; }
  else { int u = unit - 32; seq = 1 + (u >> 4); grp = (u & 15) >> 1; seg = u & 1; nseg = 2; ubase = unit & ~1; }
  const int hd = grp >> 1, dir = grp & 1;
  const int seq_start = seq == 0 ? 0 : L_PROMPT + (seq - 1) * 8192;
  const int nch = nseg * HSEG;
  int tid = tidx(p);
  asm volatile("" : "+v"(tid));
  const int w = __builtin_amdgcn_readfirstlane(tid >> 6), lane = tid & 63, r = lane & 31, h = lane >> 5;
  const int d = tid & 127, half = tid >> 7;
  const u16* gq = (const u16*)(p.ws + WS_HQ) + hd * 128;
  const u16* gg = (const u16*)(p.ws + (dir ? WS_GB : WS_GF)) + hd * 128;
  const u16* gv = (const u16*)(p.ws + WS_HV) + hd * 128;
  u16* od = (u16*)(p.ws + (dir ? WS_OB : WS_OF));
  u16* sQm = (u16*)(smem + H_QM); u16* sKm = (u16*)(smem + H_KM); u16* sQb = (u16*)(smem + H_QB);
  u16* sKlT = (u16*)(smem + H_KLT); u16* sVt = (u16*)(smem + H_VT);
  float* sDec = (float*)(smem + H_DEC);
  float* HF = (float*)(p.ws + WS_HF); float* HD = (float*)(p.ws + WS_HD);
  u32* cnt = (u32*)(p.ws + WS_MISC) + MISC_HCNT + layer * 40 + seq * 8 + grp;

  f32x16 S[4];
#pragma unroll
  for (int b = 0; b < 4; ++b)
#pragma unroll
    for (int i = 0; i < 16; ++i) S[b][i] = 0.f;

  auto chunk_t0 = [&](int c) { return seq_start + (dir ? (nch - 1 - c) : c) * 32; };
  char* rawW = smem + H_RAW + w * 8192;
  const int dcol = (w & 1) * 64;
  auto gl = [&](int c) {
    const int t0 = chunk_t0(c);
    const int row8 = lane >> 3, ch = lane & 7;
#pragma unroll
    for (int i = 0; i < 4; ++i) {
      int j = 8 * i + row8;
      size_t off = (size_t)(dir ? t0 + 31 - j : t0 + j) * 512 + dcol + ch * 8;
      __builtin_amdgcn_global_load_lds((const unsigned*)(gg + off), (unsigned*)(rawW + i * 1024 + lane * 16), 16, 0, 0);
    }
#pragma unroll
    for (int i = 0; i < 2; ++i) {
      int j = half * 16 + 8 * i + row8;
      size_t off = (size_t)(dir ? t0 + 31 - j : t0 + j) * 512 + dcol + ch * 8;
      if (PASS == 2) __builtin_amdgcn_global_load_lds((const unsigned*)(gq + off), (unsigned*)(rawW + 4096 + i * 1024 + lane * 16), 16, 0, 0);
      __builtin_amdgcn_global_load_lds((const unsigned*)(gv + off), (unsigned*)(rawW + 6144 + i * 1024 + lane * 16), 16, 0, 0);
    }
  };
  const int c_begin = seg * HSEG, c_end = c_begin + HSEG;
  __syncthreads();
  gl(c_begin);
  if (PASS == 2 && seg > 0) {
    if (tid == 0) { while (__hip_atomic_load(cnt, __ATOMIC_RELAXED, __HIP_MEMORY_SCOPE_AGENT) < (u32)nseg) __builtin_amdgcn_s_sleep(8); }
    __syncthreads();
    __threadfence();
    for (int j = 0; j < seg; ++j) {
      const float* Fj = HF + ((size_t)(ubase + j) * 256 + tid) * 64;
      const float* Dj = HD + (size_t)(ubase + j) * 128;
#pragma unroll
      for (int db = 0; db < 4; ++db)
#pragma unroll
        for (int g = 0; g < 4; ++g) {
          float4 dc = *(const float4*)(Dj + db * 32 + 8 * g + 4 * h);
          float4 f = *(const float4*)(Fj + db * 16 + 4 * g);
          S[db][4 * g] = S[db][4 * g] * dc.x + f.x; S[db][4 * g + 1] = S[db][4 * g + 1] * dc.y + f.y;
          S[db][4 * g + 2] = S[db][4 * g + 2] * dc.z + f.z; S[db][4 * g + 3] = S[db][4 * g + 3] * dc.w + f.w;
        }
    }
  }
  float logD = 0.f;
  for (int c = c_begin; c < c_end; ++c) {
    const int t0 = chunk_t0(c);
    asm volatile("s_waitcnt vmcnt(0)" ::: "memory");
    const u16* rG = (const u16*)rawW; const u16* rQ = rG + 2048; const u16* rV = rG + 3072;
    float tot0 = 0.f, tot1 = 0.f, g16;
    float gval[16]; u16 qraw[16], vraw[16];
#pragma unroll
    for (int j = 0; j < 32; ++j) {
      float g = h2f(rG[j * 64 + lane]);
      if (j < 16) tot0 += g; else tot1 += g;
      if (j == 16) g16 = g;
      if ((j >> 4) == half) gval[j & 15] = g;
    }
#pragma unroll
    for (int jj = 0; jj < 16; ++jj) { if (PASS == 2) qraw[jj] = rQ[jj * 64 + lane]; vraw[jj] = rV[jj * 64 + lane]; }
    asm volatile("s_waitcnt lgkmcnt(0)" ::: "memory");
    __builtin_amdgcn_sched_barrier(0);
    if (c + 1 < c_end) gl(c + 1);
    __syncthreads();
    const float bmid = tot0 + g16, blast = tot0 + tot1;
    logD += blast;
    float run = half ? tot0 : 0.f;
    u32 klp[8], vtp[8];
    if (PASS == 2) {
      const float Emid = __expf(bmid), Elm = __expf(blast - bmid);
#pragma unroll
      for (int jj = 0; jj < 16; jj += 2) {
        float kl2[2];
#pragma unroll
        for (int u = 0; u < 2; ++u) {
          const int j = half * 16 + jj + u;
          run += gval[jj + u];
          float e1 = __expf(run - bmid), e2 = __expf(bmid - run);
          float q = bf2f(qraw[jj + u]);
          float k = 1.f - __expf(gval[jj + u]);
          float qm = q * e1, km = k * e2;
          kl2[u] = km * Elm;
          sQm[j * HS + d] = f2bf(qm); sKm[j * HS + d] = f2bf(km); sQb[j * HS + d] = f2bf(qm * Emid);
        }
        klp[jj >> 1] = pack2bf(kl2[0], kl2[1]);
      }
    } else {
#pragma unroll
      for (int jj = 0; jj < 16; jj += 2) {
        float kl2[2];
#pragma unroll
        for (int u = 0; u < 2; ++u) {
          run += gval[jj + u];
          kl2[u] = (1.f - __expf(gval[jj + u])) * __expf(blast - run);
        }
        klp[jj >> 1] = pack2bf(kl2[0], kl2[1]);
      }
    }
#pragma unroll
    for (int jj = 0; jj < 16; jj += 2)
      vtp[jj >> 1] = (u32)vraw[jj] | ((u32)vraw[jj + 1] << 16);
    {
      u32x4 a = {klp[0], klp[1], klp[2], klp[3]}, b = {klp[4], klp[5], klp[6], klp[7]};
      *(u32x4*)(sKlT + d * VS + half * 16) = a; *(u32x4*)(sKlT + d * VS + half * 16 + 8) = b;
      u32x4 c0 = {vtp[0], vtp[1], vtp[2], vtp[3]}, c1 = {vtp[4], vtp[5], vtp[6], vtp[7]};
      *(u32x4*)(sVt + d * VS + half * 16) = c0; *(u32x4*)(sVt + d * VS + half * 16 + 8) = c1;
    }
    if (half) sDec[d] = __expf(blast);
    __syncthreads();
    if (PASS == 2) {
      f32x16 at, oT;
#pragma unroll
      for (int i = 0; i < 16; ++i) { at[i] = 0.f; oT[i] = 0.f; }
#pragma unroll
      for (int ks = 0; ks < 8; ++ks) {
        bf16x8 a = *(const bf16x8*)(sKm + r * HS + ks * 16 + 8 * h);
        bf16x8 b = *(const bf16x8*)(sQm + r * HS + ks * 16 + 8 * h);
        at = MFMA32(a, b, at);
      }
#pragma unroll
      for (int i = 0; i < 16; ++i) if (crow(i, h) > r) at[i] = 0.f;
#pragma unroll
      for (int db = 0; db < 4; ++db)
#pragma unroll
        for (int s2 = 0; s2 < 2; ++s2) {
          bf16x8 a = pack8(S[db], s2);
          s16x4 lo = *(const s16x4*)(sQb + r * HS + db * 32 + s2 * 16 + 4 * h);
          s16x4 hi = *(const s16x4*)(sQb + r * HS + db * 32 + s2 * 16 + 8 + 4 * h);
          oT = MFMA32(a, cat44(lo, hi), oT);
        }
#pragma unroll
      for (int ks = 0; ks < 2; ++ks) {
        s16x4 lo = *(const s16x4*)(sVt + (32 * w + r) * VS + 16 * ks + 4 * h);
        s16x4 hi = *(const s16x4*)(sVt + (32 * w + r) * VS + 16 * ks + 8 + 4 * h);
        oT = MFMA32(cat44(lo, hi), pack8(at, ks), oT);
      }
      int tok = dir ? t0 + 31 - r : t0 + r;
#pragma unroll
      for (int g = 0; g < 4; ++g) {
        u32x2 pk = {pack2bf(oT[4 * g], oT[4 * g + 1]), pack2bf(oT[4 * g + 2], oT[4 * g + 3])};
        *(u32x2*)(od + (size_t)tok * 512 + hd * 128 + 32 * w + 8 * g + 4 * h) = pk;
      }
    }
    if (PASS == 1 || c + 1 < c_end) {
#pragma unroll
      for (int db = 0; db < 4; ++db) {
#pragma unroll
        for (int g = 0; g < 4; ++g) {
          float4 dc = *(const float4*)(sDec + db * 32 + 8 * g + 4 * h);
          S[db][4 * g] *= dc.x; S[db][4 * g + 1] *= dc.y; S[db][4 * g + 2] *= dc.z; S[db][4 * g + 3] *= dc.w;
        }
#pragma unroll
        for (int ks = 0; ks < 2; ++ks) {
          bf16x8 a = *(const bf16x8*)(sKlT + (db * 32 + r) * VS + 16 * ks + 8 * h);
          bf16x8 b = *(const bf16x8*)(sVt + (32 * w + r) * VS + 16 * ks + 8 * h);
          S[db] = MFMA32(a, b, S[db]);
        }
      }
    }
  }
  if (PASS == 1) {
    float* Fu = HF + ((size_t)unit * 256 + tid) * 64;
#pragma unroll
    for (int db = 0; db < 4; ++db)
#pragma unroll
      for (int g = 0; g < 4; ++g)
        *(float4*)(Fu + db * 16 + 4 * g) = make_float4(S[db][4 * g], S[db][4 * g + 1], S[db][4 * g + 2], S[db][4 * g + 3]);
    if (half == 0) HD[(size_t)unit * 128 + d] = __expf(logD);
    __threadfence();
    __syncthreads();
    if (tid == 0) atomicAdd(cnt, 1u);
  }
}

DI void hgrn_finalize(const Params& p, int layer) {
  const int wave = tidx(p) >> 6, lane = tidx(p) & 63;
  u16* of = (u16*)(p.ws + WS_OF); const u16* ob = (const u16*)(p.ws + WS_OB);
  const u16* ga = (const u16*)(p.out + DO_GA);
  const float* nw = p.hgrn_norm_w + layer * 512 + lane * 8;
  float wv[8];
#pragma unroll
  for (int i = 0; i < 8; ++i) wv[i] = nw[i];
  for (int t = blockIdx.x * 4 + wave; t < T_TOK; t += gridDim.x * 4) {
    size_t off = (size_t)t * 512 + lane * 8;
    u32x4 a = *(const u32x4*)(of + off), b = *(const u32x4*)(ob + off), g = *(const u32x4*)(ga + off);
    float v[8]; float ss = 0.f;
#pragma unroll
    for (int i = 0; i < 4; ++i) {
      v[2 * i] = bflo(a[i]) + bflo(b[i]); v[2 * i + 1] = bfhi(a[i]) + bfhi(b[i]);
      ss += v[2 * i] * v[2 * i] + v[2 * i + 1] * v[2 * i + 1];
    }
    ss += __shfl_xor(ss, 1); ss += __shfl_xor(ss, 2); ss += __shfl_xor(ss, 4); ss += __shfl_xor(ss, 8);
    float rn = rsqrtf(ss * (1.f / 128.f) + EPS);
    u32x4 o;
#pragma unroll
    for (int i = 0; i < 4; ++i)
      o[i] = pack2bf(v[2 * i] * rn * wv[2 * i] * bflo(g[i]), v[2 * i + 1] * rn * wv[2 * i + 1] * bfhi(g[i]));
    *(u32x4*)(of + off) = o;
  }
}

DI int swz(int row, int lc) { return row * 64 + ((lc ^ ((row >> 1) & 7)) << 3); }

template <int NKS>
DI void attn_tile(const Params& p, int layer, int seq, int slot, int qt, char* smem, bool wr = true) {
  int tid = tidx(p);
  asm volatile("" : "+v"(tid));
  const int w = __builtin_amdgcn_readfirstlane(tid >> 6), lane = tid & 63, r = lane & 31, h = lane >> 5;
  const int sub = w >> 1, qhalf = w & 1;
  const int seq_start = seq == 0 ? 0 : L_PROMPT + (seq - 1) * 8192;
  const int L = seq == 0 ? L_PROMPT : 8192;
  const int q0 = seq_start + qt * 128 + qhalf * 64;
  const u32* misc = (const u32*)(p.ws + WS_MISC);
  const float* miscf = (const float*)misc;
  constexpr bool GQA = (NKS == 4);
  const int hd = GQA ? (2 * slot + sub) : (slot - 2);
  u16* Qb; const u16* Kb; const u16* VT; int kstride, ks0, kslot;
  if (GQA) { Qb = (u16*)(p.out + DO_BQ) + hd * 64; Kb = (const u16*)(p.out + DO_BK) + slot * 64; kstride = 128;
             VT = (const u16*)(p.out + DO_BVT) + (size_t)(slot * 64) * T_TOK; ks0 = 0; kslot = slot; }
  else { Qb = (u16*)(p.out + DO_CQ) + hd * 64 + 32 * sub; Kb = (const u16*)(p.out + DO_CK) + hd * 64; kstride = 256;
         VT = (const u16*)(p.ws + WS_CVT) + (size_t)(hd * 64) * T_TOK; ks0 = 2 * sub; kslot = 2 + hd * 2 + sub; }
  const float kmax = sqrtf(__uint_as_float(misc[layer * 50 + seq * 10 + kslot]));

  bf16x8 qf[2][NKS]; float ncb[2], lsum[2];
  f32x16 O[2][2];
#pragma unroll
  for (int qb = 0; qb < 2; ++qb) {
    float ss = 0.f;
#pragma unroll
    for (int ks = 0; ks < NKS; ++ks) {
      u32x4 v = *(const u32x4*)(Qb + (size_t)(q0 + 32 * qb + r) * 256 + 16 * ks + 8 * h);
      qf[qb][ks] = __builtin_bit_cast(bf16x8, v);
#pragma unroll
      for (int i = 0; i < 4; ++i) { float a = bflo(v[i]), b = bfhi(v[i]); ss += a * a + b * b; }
    }
    ss += xhalf(ss);
    ncb[qb] = -sqrtf(ss) * kmax; lsum[qb] = 0.f;
#pragma unroll
    for (int eb = 0; eb < 2; ++eb)
#pragma unroll
      for (int i = 0; i < 16; ++i) O[qb][eb][i] = 0.f;
  }

  auto stage = [&](int kt) {
    const int k0 = seq_start + kt * 128;
    char* base = smem + (kt & 1) * 32768;
#pragma unroll 1
    for (int i = 0; i < 4; ++i) {
      int c = tid + 256 * i; int row = c >> 3, lc = (c & 7) ^ ((row >> 1) & 7);
      __builtin_amdgcn_global_load_lds((const unsigned*)(Kb + (size_t)(k0 + row) * kstride + lc * 8), (unsigned*)(base + c * 16), 16, 0, 0);
      int sub = c >> 9, er = (c & 511) >> 3;
      __builtin_amdgcn_global_load_lds((const unsigned*)(VT + (size_t)er * T_TOK + k0 + sub * 64 + lc * 8), (unsigned*)(base + 16384 + c * 16), 16, 0, 0);
    }
  };
  const int nkt = L >> 7;
  const bool fast = wave_max(fmaxf(-ncb[0], -ncb[1])) < 60.f;
  f32x4m ls4[2];
#pragma unroll
  for (int qb = 0; qb < 2; ++qb)
#pragma unroll
    for (int i = 0; i < 4; ++i) ls4[qb][i] = 0.f;
  bf16x8 selA;
  {
    const int r16 = lane & 15, grp = lane >> 4;
    const short one = ((r16 == 0 && (grp & 1) == 0) || (r16 == 1 && (grp & 1) == 1)) ? (short)0x3F80 : (short)0;
#pragma unroll
    for (int i = 0; i < 8; ++i) selA[i] = one;
  }
  auto mainloop = [&](auto SUBT) {
    constexpr bool SUB = decltype(SUBT)::value;
    for (int kt = 0; kt < nkt; ++kt) {
      asm volatile("s_waitcnt vmcnt(0)" ::: "memory");
      __syncthreads();
      if (kt + 1 < nkt) stage(kt + 1);
#pragma unroll 1
      for (int kh = 0; kh < 2; ++kh) {
      const u16* sK = (const u16*)(smem + (kt & 1) * 32768 + kh * 8192);
      const u16* sV = (const u16*)(smem + (kt & 1) * 32768 + 16384 + kh * 8192);
      auto kb_body = [&](int kb) {
        bf16x8 kf[NKS];
#pragma unroll
        for (int ks = 0; ks < NKS; ++ks) kf[ks] = *(const bf16x8*)(sK + swz(32 * kb + r, 2 * (ks0 + ks) + h));
        bf16x8 pk[2][2];
#pragma unroll
        for (int qb = 0; qb < 2; ++qb) {
          f32x16 st;
#pragma unroll
          for (int i = 0; i < 16; ++i) st[i] = SUB ? ncb[qb] : 0.f;
#pragma unroll
          for (int ks = 0; ks < NKS; ++ks) st = MFMA32(kf[ks], qf[qb][ks], st);
          if constexpr (SUB) {
            float ls = 0.f;
#pragma unroll
            for (int i = 0; i < 16; ++i) { float e = __builtin_amdgcn_exp2f(st[i]); st[i] = e; ls = fadd1(ls, e); }
            lsum[qb] += ls;
            pk[qb][0] = pack8(st, 0); pk[qb][1] = pack8(st, 1);
          } else {
#pragma unroll
            for (int i = 0; i < 16; ++i) st[i] = __builtin_amdgcn_exp2f(st[i]);
            pk[qb][0] = pack8(st, 0); pk[qb][1] = pack8(st, 1);
            ls4[qb] = __builtin_amdgcn_mfma_f32_16x16x32_bf16(selA, pk[qb][0], ls4[qb], 0, 0, 0);
            ls4[qb] = __builtin_amdgcn_mfma_f32_16x16x32_bf16(selA, pk[qb][1], ls4[qb], 0, 0, 0);
          }
        }
#pragma unroll
        for (int eb = 0; eb < 2; ++eb)
#pragma unroll
          for (int s2 = 0; s2 < 2; ++s2) {
            bf16x8 vf = *(const bf16x8*)(sV + swz(32 * eb + r, 4 * kb + 2 * s2 + h));
#pragma unroll
            for (int qb = 0; qb < 2; ++qb) O[qb][eb] = MFMA32(vf, pk[qb][s2], O[qb][eb]);
          }
      };
      if constexpr (SUB) {
#pragma unroll 1
        for (int kb = 0; kb < 2; ++kb) kb_body(kb);
      } else {
        kb_body(0); kb_body(1);
      }
      }
    }
  };
  __syncthreads();
  stage(0);
  if (fast) mainloop(std::false_type{}); else mainloop(std::true_type{});
  if (fast) {
#pragma unroll
    for (int qb = 0; qb < 2; ++qb) {
      const float v0 = __shfl(ls4[qb][0], lane & 15), v1 = __shfl(ls4[qb][1], lane & 15);
      lsum[qb] = 0.5f * ((lane & 16) ? v1 : v0);
    }
  }
  __syncthreads();
  if (GQA) {
    const u16* gate = (const u16*)(p.out + DO_GB) + hd * 64;
#pragma unroll
    for (int qb = 0; qb < 2; ++qb) {
      const float inv = 1.f / (lsum[qb] + xhalf(lsum[qb]));
      const size_t t = (size_t)(q0 + 32 * qb + r);
#pragma unroll
      for (int eb = 0; eb < 2; ++eb)
#pragma unroll
        for (int g = 0; g < 4; ++g) {
          int e = 32 * eb + 8 * g + 4 * h;
          u32x2 gt = *(const u32x2*)(gate + t * 256 + e);
          u32x2 o = {pack2bf(O[qb][eb][4 * g] * inv * bflo(gt[0]), O[qb][eb][4 * g + 1] * inv * bfhi(gt[0])),
                     pack2bf(O[qb][eb][4 * g + 2] * inv * bflo(gt[1]), O[qb][eb][4 * g + 3] * inv * bfhi(gt[1]))};
          if (wr) *(u32x2*)(Qb + t * 256 + e) = o;
        }
    }
  } else {
    float* xch = (float*)smem;
    const float lam = miscf[104 + layer];
    const float post = 1.f - (0.8f - 0.6f * __expf(-0.3f * (float)layer));
    const u16* gate = (const u16*)(p.out + DO_GC) + hd * 64;
    u16* outb = (u16*)(p.out + DO_CQ) + hd * 64;
    const float* dnw = p.diff_norm_w + layer * 64;
#pragma unroll
    for (int qb = 0; qb < 2; ++qb) {
      const float inv = 1.f / (lsum[qb] + xhalf(lsum[qb]));
      if (sub == 1) {
#pragma unroll
        for (int eb = 0; eb < 2; ++eb)
#pragma unroll
          for (int i = 0; i < 16; ++i) xch[(qhalf * 32 + eb * 16 + i) * 64 + lane] = O[qb][eb][i] * inv;
      }
      __syncthreads();
      if (sub == 0) {
        float ss = 0.f;
#pragma unroll
        for (int eb = 0; eb < 2; ++eb)
#pragma unroll
          for (int i = 0; i < 16; ++i) {
            float v = O[qb][eb][i] * inv - lam * xch[(qhalf * 32 + eb * 16 + i) * 64 + lane];
            O[qb][eb][i] = v; ss += v * v;
          }
        ss += xhalf(ss);
        const float rn = rsqrtf(ss * (1.f / 64.f) + EPS) * post;
        const size_t t = (size_t)(q0 + 32 * qb + r);
#pragma unroll
        for (int eb = 0; eb < 2; ++eb)
#pragma unroll
          for (int g = 0; g < 4; ++g) {
            int e = 32 * eb + 8 * g + 4 * h;
            u32x2 gt = *(const u32x2*)(gate + t * 256 + e);
            float4 nw = *(const float4*)(dnw + e);
            u32x2 o = {pack2bf(O[qb][eb][4 * g] * rn * nw.x * bflo(gt[0]), O[qb][eb][4 * g + 1] * rn * nw.y * bfhi(gt[0])),
                       pack2bf(O[qb][eb][4 * g + 2] * rn * nw.z * bflo(gt[1]), O[qb][eb][4 * g + 3] * rn * nw.w * bfhi(gt[1]))};
            if (wr) *(u32x2*)(outb + t * 256 + e) = o;
          }
      }
      __syncthreads();
    }
  }
}

template <int NKS>
DI void attn_loop(const Params& p, int layer, char* smem, bool wr = true) {
  constexpr int NSLOT = NKS == 4 ? 2 : 4, SLOT0 = NKS == 4 ? 0 : 2;
  u32* ctr = (u32*)(p.ws + WS_MISC) + (wr ? 100 : MISC_HCNT + 90) + layer * 2 + (NKS == 4 ? 0 : 1);
  int* s_tile = (int*)(smem + SMEM_BYTES - 16);
  for (;;) {
    __syncthreads();
    if (tidx(p) == 0) *s_tile = (int)atomicAdd(ctr, 1u);
    __syncthreads();
    const int idx = __builtin_amdgcn_readfirstlane(*s_tile);
    if (idx >= NSLOT * 384) break;
    int seq, slot, qt;
    if (idx < NSLOT * 128) { seq = 0; slot = idx >> 7; qt = idx & 127; }
    else { int i2 = idx - NSLOT * 128; seq = 1 + i2 / (NSLOT * 64); int rem = i2 % (NSLOT * 64); slot = rem >> 6; qt = rem & 63; }
    attn_tile<NKS>(p, layer, seq, SLOT0 + slot, qt, smem, wr);
  }
}

DI void mixer_phase(const Params& p, int layer, char* smem) {
  for (int u = blockIdx.x; u < H_UNITS; u += gridDim.x) hgrn_unit<1>(p, layer, u, smem);
  for (int u = blockIdx.x; u < H_UNITS; u += gridDim.x) hgrn_unit<2>(p, layer, u, smem);
#ifdef PROBE_DUP_ATTN
  if (p.dry) { attn_loop<2>(p, layer, smem, false); attn_loop<4>(p, layer, smem, false); }
#endif
  attn_loop<4>(p, layer, smem);
  attn_loop<2>(p, layer, smem);
}

template <int PH>
DI void run_phase(const Params& p, char* smem) {
  if (PH == 0) { phase0(p, smem); return; }
  constexpr int layer = (PH - 1) / 5, s = (PH - 1) % 5;
  if (s == 0) { gemm_phase<true>(p, layer, smem);
#ifdef PROBE_DUP_GIN
    __syncthreads(); gemm_phase<true>(p, layer, smem);
#endif
  }
  else if (s == 1) mixer_phase(p, layer, smem);
  else if (s == 2) hgrn_finalize(p, layer);
  else if (s == 3) { gemm_phase<false>(p, layer, smem);
#ifdef PROBE_DUP_GOUT
    __syncthreads(); gemm_phase<false>(p, layer, smem);
#endif
  }
  else rowprep(p, layer == 0 ? 1 : 2);
}

DI void grid_barrier(const Params& p, unsigned k) {
  __syncthreads();
  if (tidx(p) == 0) {
    u32* bar = (u32*)(p.ws + WS_MISC) + MISC_BAR2;
    const unsigned g = blockIdx.x & 7u, gsize = gridDim.x >> 3;
    __threadfence();
    const unsigned t = __hip_atomic_fetch_add(bar + g * 64, 1u, __ATOMIC_RELAXED, __HIP_MEMORY_SCOPE_AGENT);
    if (t + 1 == k * gsize) {
      __hip_atomic_fetch_add(bar + 1024, 1u, __ATOMIC_RELAXED, __HIP_MEMORY_SCOPE_AGENT);
      while (__hip_atomic_load(bar + 1024, __ATOMIC_RELAXED, __HIP_MEMORY_SCOPE_AGENT) < 8u * k) __builtin_amdgcn_s_sleep(2);
      __hip_atomic_store(bar + 512 + g * 64, k, __ATOMIC_RELAXED, __HIP_MEMORY_SCOPE_AGENT);
    } else {
      while (__hip_atomic_load(bar + 512 + g * 64, __ATOMIC_RELAXED, __HIP_MEMORY_SCOPE_AGENT) < k) __builtin_amdgcn_s_sleep(2);
    }
    __threadfence();
  }
  __syncthreads();
}

#ifndef MULTI_LAUNCH
__global__ void __launch_bounds__(256, 2) hymba_mega(Params p0) {
  __shared__ __attribute__((aligned(16))) char smem[SMEM_BYTES];
  Params p = p0;
  p.wid = __builtin_amdgcn_readfirstlane(threadIdx.x >> 6);
  const unsigned nb = gridDim.x;
  run_phase<0>(p, smem); cg::this_grid().sync();
  run_phase<1>(p, smem); grid_barrier(p, 1);
  run_phase<2>(p, smem); grid_barrier(p, 2);
  run_phase<3>(p, smem); grid_barrier(p, 3);
  run_phase<4>(p, smem); grid_barrier(p, 4);
  run_phase<5>(p, smem); grid_barrier(p, 5);
  run_phase<6>(p, smem); grid_barrier(p, 6);
  run_phase<7>(p, smem); grid_barrier(p, 7);
  run_phase<8>(p, smem); grid_barrier(p, 8);
  run_phase<9>(p, smem); grid_barrier(p, 9);
  run_phase<10>(p, smem);
}
#else
template <int PH>
__global__ void __launch_bounds__(256, 2) hymba_phase(Params p0) {
  __shared__ __attribute__((aligned(16))) char smem[SMEM_BYTES];
  Params p = p0;
  p.wid = __builtin_amdgcn_readfirstlane(threadIdx.x >> 6);
  run_phase<PH>(p, smem);
}
#endif

extern "C" void kernel_launch(void* const* d_in, const int* in_sizes, int n_in, void* d_out, int out_size,
                              void* d_ws, size_t ws_size, hipStream_t stream) {
  static int grid_blocks = 0;
  if (!grid_blocks) {
    int dev = 0, cus = 0, per_cu = 2;
    (void)hipGetDevice(&dev);
    (void)hipDeviceGetAttribute(&cus, hipDeviceAttributeMultiprocessorCount, dev);
#ifndef MULTI_LAUNCH
    (void)hipOccupancyMaxActiveBlocksPerMultiprocessor(&per_cu, hymba_mega, 256, 0);
#endif
    if (per_cu > 2) per_cu = 2;
    if (per_cu < 1) per_cu = 1;
    grid_blocks = cus * per_cu;
  }
  Params p;
  memset(&p, 0, sizeof(p));
  p.x_prompt = (const float*)d_in[0]; p.x_sample = (const float*)d_in[1]; p.pre_norm_w = (const float*)d_in[2];
  p.w_in = (const float*)d_in[3]; p.hgrn_lb = (const float*)d_in[4]; p.hgrn_norm_w = (const float*)d_in[5];
  p.gqa_q_norm_w = (const float*)d_in[6]; p.gqa_k_norm_w = (const float*)d_in[7]; p.diff_lambda = (const float*)d_in[8];
  p.diff_norm_w = (const float*)d_in[9]; p.w_out = (const float*)d_in[10]; p.post_norm_w = (const float*)d_in[11];
  p.out = (char*)d_out; p.ws = (char*)d_ws;
#ifdef PROBE_DUP_ATTN
  p.dry = 1;
#endif
#ifndef MULTI_LAUNCH
  void* args[] = {&p};
  hipError_t e = hipLaunchCooperativeKernel((void*)hymba_mega, dim3(grid_blocks), dim3(256), args, 0, stream);
  if (e != hipSuccess) fprintf(stderr, "cooperative launch failed: %s (grid %d)\n", hipGetErrorString(e), grid_blocks);
#else
  dim3 g(grid_blocks), b(256);
  hymba_phase<0><<<g, b, 0, stream>>>(p); hymba_phase<1><<<g, b, 0, stream>>>(p); hymba_phase<2><<<g, b, 0, stream>>>(p);
  hymba_phase<3><<<g, b, 0, stream>>>(p); hymba_phase<4><<<g, b, 0, stream>>>(p); hymba_phase<5><<<g, b, 0, stream>>>(p);
  hymba_phase<6><<<g, b, 0, stream>>>(p); hymba_phase<7><<<g, b, 0, stream>>>(p); hymba_phase<8><<<g, b, 0, stream>>>(p);
  hymba_phase<9><<<g, b, 0, stream>>>(p); hymba_phase<10><<<g, b, 0, stream>>>(p);
#endif
}
```

```cpp
#include <hip/hip_runtime.h>
#include <hip/hip_cooperative_groups.h>
#include <cstdio>
#include <cmath>
#include <cstring>
#include <type_traits>
namespace cg = cooperative_groups;

#define DI __device__ __forceinline__
typedef unsigned short u16;
typedef unsigned int u32;
using bf16x8 = __attribute__((ext_vector_type(8))) short;
using s16x4  = __attribute__((ext_vector_type(4))) short;
using f32x16 = __attribute__((ext_vector_type(16))) float;
using f32x2  = __attribute__((ext_vector_type(2))) float;
using f32x4m = __attribute__((ext_vector_type(4))) float;
using bf2_t  = __attribute__((ext_vector_type(2))) __bf16;
using u32x4  = __attribute__((ext_vector_type(4))) unsigned;
using u32x2  = __attribute__((ext_vector_type(2))) unsigned;
#define MFMA32(a, b, c) __builtin_amdgcn_mfma_f32_32x32x16_bf16((a), (b), (c), 0, 0, 0)

constexpr int T_TOK = 49152;
constexpr int L_PROMPT = 16384;
constexpr int DM = 1024;
constexpr int NCOL = 4352;
constexpr float EPS = 1e-6f;
constexpr float LOG2E = 1.4426950408889634f;
constexpr size_t MiB = 1u << 20;

constexpr size_t WS_HQ = 0;
constexpr size_t WS_GF = 48 * MiB;
constexpr size_t WS_GB = 96 * MiB;
constexpr size_t WS_HV = 144 * MiB;
constexpr size_t WS_Y = 0;
constexpr size_t WS_CVT = 192 * MiB;
constexpr size_t WS_XB = 216 * MiB;
constexpr size_t WS_OF = WS_XB;
constexpr size_t WS_OB = WS_XB + 48 * MiB;
constexpr size_t WS_R0 = 312 * MiB;
constexpr size_t WS_WIN = 408 * MiB;
constexpr size_t WS_WOUT = 425 * MiB;
constexpr size_t WS_TAB = 429 * MiB;
constexpr size_t WS_RSTD = 431 * MiB;
constexpr size_t WS_MISC = 431 * MiB + 256 * 1024;
constexpr size_t WS_HF = 432 * MiB;
constexpr size_t WS_HD = 456 * MiB;
constexpr int MISC_HCNT = 1200;
constexpr int MISC_BAR = 1400;
constexpr int MISC_BAR2 = 4096;
constexpr int MISC_GCTR = 1440;
constexpr size_t DO_BQ = 0;
constexpr size_t DO_CQ = 24 * MiB;
constexpr size_t DO_GA = 48 * MiB;
constexpr size_t DO_GB = 96 * MiB;
constexpr size_t DO_GC = 120 * MiB;
constexpr size_t DO_BK = 144 * MiB;
constexpr size_t DO_BVT = 156 * MiB;
constexpr size_t DO_CK = 168 * MiB;

constexpr float QS_GQA = 0.125f * LOG2E;
constexpr float QS_DIFF = 0.17677669529663687f * LOG2E;

struct Params {
  const float* x_prompt; const float* x_sample; const float* pre_norm_w; const float* w_in;
  const float* hgrn_lb; const float* hgrn_norm_w; const float* gqa_q_norm_w; const float* gqa_k_norm_w;
  const float* diff_lambda; const float* diff_norm_w; const float* w_out; const float* post_norm_w;
  char* out; char* ws;
  int dry; int wid;
};
DI int tidx(const Params& p) {
  int l = (int)__builtin_amdgcn_mbcnt_hi(~0u, __builtin_amdgcn_mbcnt_lo(~0u, 0u));
  asm volatile("" : "+v"(l));
  return p.wid * 64 + l;
}

DI u32 pack2bf(float lo, float hi) { f32x2 v = {lo, hi}; return __builtin_bit_cast(u32, __builtin_convertvector(v, bf2_t)); }
DI u16 f2bf(float x) { return (u16)(pack2bf(x, 0.f) & 0xffffu); }
DI float bf2f(u16 b) { return __uint_as_float(((u32)b) << 16); }
DI float bflo(u32 w) { return __uint_as_float(w << 16); }
DI float bfhi(u32 w) { return __uint_as_float(w & 0xffff0000u); }
DI u16 f2h(float x) { _Float16 h = (_Float16)x; return __builtin_bit_cast(u16, h); }
DI float h2f(u16 b) { return (float)__builtin_bit_cast(_Float16, b); }
DI unsigned xcc_id() { return (unsigned)__builtin_amdgcn_s_getreg((3 << 11) | 20) & 0xFu; }
DI int crow(int i, int h) { return (i & 3) + 8 * (i >> 2) + 4 * h; }
DI bf16x8 pack8(const f32x16& x, int s) {
  u32x4 p;
  p[0] = pack2bf(x[8 * s + 0], x[8 * s + 1]); p[1] = pack2bf(x[8 * s + 2], x[8 * s + 3]);
  p[2] = pack2bf(x[8 * s + 4], x[8 * s + 5]); p[3] = pack2bf(x[8 * s + 6], x[8 * s + 7]);
  return __builtin_bit_cast(bf16x8, p);
}
DI bf16x8 cat44(s16x4 lo, s16x4 hi) { return __builtin_shufflevector(lo, hi, 0, 1, 2, 3, 4, 5, 6, 7); }
DI float fadd1(float a, float b) { float r; asm("v_add_f32 %0, %1, %2" : "=v"(r) : "v"(a), "v"(b)); return r; }
DI float xhalf(float v) { return __shfl_xor(v, 32); }
DI float wave_sum(float v) { for (int o = 32; o; o >>= 1) v += __shfl_xor(v, o); return v; }
DI float wave_max(float v) { for (int o = 32; o; o >>= 1) v = fmaxf(v, __shfl_xor(v, o)); return v; }
DI float sigm(float x) { return __builtin_amdgcn_rcpf(1.f + __builtin_amdgcn_exp2f(-LOG2E * x)); }
DI int seq_of(int t) { return t < L_PROMPT ? 0 : 1 + ((t - L_PROMPT) >> 13); }
DI int pos_of(int t) { return t < L_PROMPT ? t : (t & 8191); }

DI void transpose_unit(const Params& p, int u, char* smem) {
  u16* tile = (u16*)smem;
  const int tid = tidx(p);
  const float* src; u16* dst; const float* rw = nullptr; int N, kt, nt;
  if (u < 2176) { int l = u / 1088, r = u % 1088; kt = r / 68; nt = r % 68; N = NCOL;
    src = p.w_in + (size_t)l * DM * NCOL; dst = (u16*)(p.ws + WS_WIN) + (size_t)l * NCOL * DM; rw = p.pre_norm_w + l * DM; }
  else { int v = u - 2176; int l = v / 256, r = v % 256; kt = r / 16; nt = r % 16; N = DM;
    src = p.w_out + (size_t)l * DM * DM; dst = (u16*)(p.ws + WS_WOUT) + (size_t)l * DM * DM; }
  const int c4 = (tid & 15) * 4, r0 = tid >> 4;
  __syncthreads();
#pragma unroll
  for (int i = 0; i < 4; ++i) {
    int r = r0 + 16 * i; int k = kt * 64 + r;
    float4 v = *(const float4*)(src + (size_t)k * N + nt * 64 + c4);
    float w = rw ? rw[k] : 1.f;
    tile[(c4 + 0) * 72 + r] = f2bf(v.x * w); tile[(c4 + 1) * 72 + r] = f2bf(v.y * w);
    tile[(c4 + 2) * 72 + r] = f2bf(v.z * w); tile[(c4 + 3) * 72 + r] = f2bf(v.w * w);
  }
  __syncthreads();
#pragma unroll
  for (int i = 0; i < 2; ++i) {
    int n = (tid >> 3) + 32 * i, ch = tid & 7;
    u32x4 v = *(const u32x4*)(tile + n * 72 + ch * 8);
    *(u32x4*)(dst + (size_t)(nt * 64 + n) * DM + kt * 64 + ch * 8) = v;
  }
}

DI void sincos_d(double x, float& c, float& s) {
  const double x2 = x * x;
  double ts = 0.0, tc = 0.0;
#pragma unroll
  for (int n = 14; n >= 1; --n) {
    const double cs_ = -1.0 / (double)((2 * n) * (2 * n + 1));
    const double cc_ = -1.0 / (double)((2 * n - 1) * (2 * n));
    ts = (1.0 + ts) * (x2 * cs_);
    tc = (1.0 + tc) * (x2 * cc_);
  }
  c = (float)(1.0 + tc); s = (float)(x * (1.0 + ts));
}

DI void table_unit(const Params& p, int u) {
  int idx = u * 256 + tidx(p);
  int i = idx >> 14, pos = idx & 16383;
  const int i4 = i & 3, i16 = i >> 2;
  double inv = i4 == 0 ? 1.0 : (i4 == 1 ? 0.5623413251903491 : (i4 == 2 ? 0.31622776601683794 : 0.1778279410038923));
  inv *= i16 == 0 ? 1.0 : (i16 == 1 ? 0.1 : (i16 == 2 ? 0.01 : 0.001));
  double ang = (double)pos * inv;
  double rev = ang * 0.15915494309189535;
  rev -= rint(rev);
  float c, s; sincos_d(rev * 6.283185307179586, c, s);
  ((float2*)(p.ws + WS_TAB))[idx] = make_float2(c, s);
}

using f32x4v = __attribute__((ext_vector_type(4))) float;
DI float4 ntload4(const float* ptr) { f32x4v v = __builtin_nontemporal_load((const f32x4v*)ptr); return make_float4(v[0], v[1], v[2], v[3]); }
DI const float* x_row(const Params& p, int row) {
  return row < L_PROMPT ? p.x_prompt + (size_t)row * DM : p.x_sample + (size_t)(row - L_PROMPT) * DM;
}

DI void rowprep(const Params& p, int mode) {
  const int wave = tidx(p) >> 6, lane = tidx(p) & 63;
  const u16* yb = (const u16*)(p.ws + WS_Y);
  u16* r0b = (u16*)(p.ws + WS_R0);
  u16* xb = (u16*)(p.ws + WS_XB);
  float* rstd = (float*)(p.ws + WS_RSTD);
  const float* pw = p.post_norm_w + (mode == 2 ? DM : 0);
  for (int row = blockIdx.x * 4 + wave; row < T_TOK; row += gridDim.x * 4) {
    const float* x0 = x_row(p, row);
    float4 xv[4];
#pragma unroll
    for (int i = 0; i < 4; ++i) xv[i] = ntload4(x0 + lane * 4 + 256 * i);
    if (mode >= 1) {
      float4 yv[4]; float ss = 0.f;
#pragma unroll
      for (int i = 0; i < 4; ++i) {
        { u32x2 yp = *(const u32x2*)(yb + (size_t)row * DM + lane * 4 + 256 * i);
          yv[i] = make_float4(bflo(yp[0]), bfhi(yp[0]), bflo(yp[1]), bfhi(yp[1])); }
        ss += yv[i].x * yv[i].x + yv[i].y * yv[i].y + yv[i].z * yv[i].z + yv[i].w * yv[i].w;
      }
      ss = wave_sum(ss);
      float rs = rsqrtf(ss * (1.f / DM) + EPS);
#pragma unroll
      for (int i = 0; i < 4; ++i) {
        float4 w = *(const float4*)(pw + lane * 4 + 256 * i);
        float4 r = make_float4(yv[i].x * rs * w.x, yv[i].y * rs * w.y, yv[i].z * rs * w.z, yv[i].w * rs * w.w);
        size_t off = (size_t)row * DM + lane * 4 + 256 * i;
        if (mode == 1) {
          u16 h0 = f2h(r.x), h1 = f2h(r.y), h2 = f2h(r.z), h3 = f2h(r.w);
          u32x2 pk = {(u32)h0 | ((u32)h1 << 16), (u32)h2 | ((u32)h3 << 16)};
          __builtin_nontemporal_store(pk, (u32x2*)(r0b + off));
          xv[i].x += h2f(h0); xv[i].y += h2f(h1); xv[i].z += h2f(h2); xv[i].w += h2f(h3);
        } else {
          u32x2 pk = *(const u32x2*)(r0b + off);
          float4 o;
          o.x = (xv[i].x + h2f((u16)(pk[0] & 0xffff))) + r.x;
          o.y = (xv[i].y + h2f((u16)(pk[0] >> 16))) + r.y;
          o.z = (xv[i].z + h2f((u16)(pk[1] & 0xffff))) + r.z;
          o.w = (xv[i].w + h2f((u16)(pk[1] >> 16))) + r.w;
          { f32x4v ov = {o.x, o.y, o.z, o.w}; __builtin_nontemporal_store(ov, (f32x4v*)((float*)p.out + off)); }
        }
      }
    }
    if (mode <= 1) {
      float ss = 0.f;
#pragma unroll
      for (int i = 0; i < 4; ++i) {
        ss += xv[i].x * xv[i].x + xv[i].y * xv[i].y + xv[i].z * xv[i].z + xv[i].w * xv[i].w;
        u32x2 pk = {pack2bf(xv[i].x, xv[i].y), pack2bf(xv[i].z, xv[i].w)};
        *(u32x2*)(xb + (size_t)row * DM + lane * 4 + 256 * i) = pk;
      }
      ss = wave_sum(ss);
      if (lane == 0) rstd[row] = rsqrtf(ss * (1.f / DM) + EPS);
    }
  }
}

DI void phase0(const Params& p, char* smem) {
  const int nb = gridDim.x, b = blockIdx.x;
  for (int u = b; u < 2688; u += nb) transpose_unit(p, u, smem);
  for (int u = b; u < 1024; u += nb) table_unit(p, u);
  rowprep(p, 0);
  if (b == 0) {
    u32* misc = (u32*)(p.ws + WS_MISC);
    float* miscf = (float*)misc;
    const int tid = tidx(p);
    if (tid < 104) misc[tid] = 0u;
    if (tid < 96) misc[MISC_HCNT + tid] = 0u;
    for (int i = tid; i < 1100; i += 256) misc[MISC_BAR2 + i] = 0u;
    if (tid < 32) misc[MISC_GCTR + tid] = 0u;
    if (tid < 2) {
      const float* lp = p.diff_lambda + tid * 128;
      float a = 0.f, c = 0.f;
      for (int i = 0; i < 32; ++i) { a += lp[i] * lp[32 + i]; c += lp[64 + i] * lp[96 + i]; }
      float lam_init = 0.8f - 0.6f * expf(-0.3f * (float)tid);
      miscf[104 + tid] = expf(a) - expf(c) + lam_init;
    }
    for (int i = tid; i < 1024; i += 256) {
      float a0 = p.hgrn_lb[i], a1 = p.hgrn_lb[1024 + i];
      miscf[128 + i] = 1.f / (1.f + expf(a0 - a1));
    }
  }
}

constexpr int HS = 136;
constexpr int VS = 40;
constexpr int H_QM = 0, H_KM = 8704, H_QB = 17408, H_KLT = 26112, H_VT = 36352, H_DEC = 46592;
constexpr int H_RAW = 47104;
constexpr int SMEM_BYTES = 47104 + 32768 + 16;
constexpr int GS = 72;
constexpr int CS = 136;

enum { K_SILU = 0, K_COPY, K_G, K_QN, K_KN, K_VT, K_CQ, K_CK };

struct TileDesc { int kind; u16* dst; int stride; int col; int aux; };

DI TileDesc tile_desc(const Params& p, int nt) {
  TileDesc d; d.aux = 0;
  char* ws = p.ws; char* o = p.out;
  if (nt < 4)       { d.kind = K_SILU; d.dst = (u16*)(ws + WS_HQ); d.stride = 512; d.col = nt * 128; }
  else if (nt < 8)  { d.kind = K_G;    d.dst = (u16*)(ws + WS_GF); d.stride = 512; d.col = (nt - 4) * 128; d.aux = 0; }
  else if (nt < 12) { d.kind = K_G;    d.dst = (u16*)(ws + WS_GB); d.stride = 512; d.col = (nt - 8) * 128; d.aux = 1; }
  else if (nt < 16) { d.kind = K_COPY; d.dst = (u16*)(ws + WS_HV); d.stride = 512; d.col = (nt - 12) * 128; }
  else if (nt < 20) { d.kind = K_SILU; d.dst = (u16*)(o + DO_GA);  d.stride = 512; d.col = (nt - 16) * 128; }
  else if (nt < 22) { d.kind = K_QN;   d.dst = (u16*)(o + DO_BQ);  d.stride = 256; d.col = (nt - 20) * 128; }
  else if (nt < 23) { d.kind = K_KN;   d.dst = (u16*)(o + DO_BK);  d.stride = 128; d.col = 0; }
  else if (nt < 24) { d.kind = K_VT;   d.dst = (u16*)(o + DO_BVT); d.stride = T_TOK; d.col = 0; }
  else if (nt < 26) { d.kind = K_SILU; d.dst = (u16*)(o + DO_GB);  d.stride = 256; d.col = (nt - 24) * 128; }
  else if (nt < 28) { d.kind = K_CQ;   d.dst = (u16*)(o + DO_CQ);  d.stride = 256; d.col = (nt - 26) * 128; }
  else if (nt < 30) { d.kind = K_CK;   d.dst = (u16*)(o + DO_CK);  d.stride = 256; d.col = (nt - 28) * 128; d.aux = (nt - 28); }
  else if (nt < 32) { d.kind = K_VT;   d.dst = (u16*)(ws + WS_CVT); d.stride = T_TOK; d.col = (nt - 30) * 128; }
  else              { d.kind = K_SILU; d.dst = (u16*)(o + DO_GC);  d.stride = 256; d.col = (nt - 32) * 128; }
  return d;
}

DI void rope_pairs(f32x16& x, const float2* tab, int pos, int h, float scale) {
#pragma unroll
  for (int i = 0; i < 8; ++i) {
    int idx = crow(i, h);
    float2 cs = tab[idx * 16384 + pos];
    float a = x[i], b = x[i + 8];
    x[i] = (a * cs.x - b * cs.y) * scale;
    x[i + 8] = (b * cs.x + a * cs.y) * scale;
  }
}

DI void rope32(float* x, const float2* tab, int pos, float scale) {
#pragma unroll
  for (int j = 0; j < 16; ++j) {
    float2 cs = tab[j * 16384 + pos];
    float a = x[j], b = x[j + 16];
    x[j] = (a * cs.x - b * cs.y) * scale;
    x[j + 16] = (b * cs.x + a * cs.y) * scale;
  }
}
DI void qk_post(const Params& p, int layer, int nt, int t0, int tid, char* smem) {
  const float2* tab = (const float2*)(p.ws + WS_TAB);
  u32* misc = (u32*)(p.ws + WS_MISC);
  const int tl = tid & 127, hh = __builtin_amdgcn_readfirstlane(tid >> 7), lane = tid & 63;
  const int pos = pos_of(t0 + tl), seq = seq_of(t0);
#pragma unroll 1
  for (int hf = 0; hf < 2; ++hf) {
    const TileDesc d = tile_desc(p, nt * 2 + hf);
    if (d.kind != K_QN && d.kind != K_KN && d.kind != K_CQ && d.kind != K_CK) continue;
    u16* row = (u16*)(smem + hf * 34816) + tl * CS + hh * 64;
    float x[64];
#pragma unroll
    for (int c = 0; c < 8; ++c) {
      u32x4 v = *(const u32x4*)(row + c * 8);
#pragma unroll
      for (int i = 0; i < 4; ++i) { x[c * 8 + 2 * i] = bflo(v[i]); x[c * 8 + 2 * i + 1] = bfhi(v[i]); }
    }
    if (d.kind == K_QN || d.kind == K_KN) {
      const float* nw = (d.kind == K_QN ? p.gqa_q_norm_w : p.gqa_k_norm_w) + layer * 64;
      float ss = 0.f;
#pragma unroll
      for (int j = 0; j < 64; ++j) ss += x[j] * x[j];
      const float rn = rsqrtf(ss * (1.f / 64.f) + EPS);
      float s2 = 0.f;
#pragma unroll
      for (int j = 0; j < 64; ++j) { x[j] *= rn * nw[j]; s2 += x[j] * x[j]; }
      const float sc = d.kind == K_QN ? QS_GQA : 1.f;
      rope32(x, tab, pos >> 6, sc);
      rope32(x + 32, tab, pos & 63, sc);
      if (d.kind == K_KN) {
        s2 = wave_max(s2);
        if (lane == 0) atomicMax(&misc[layer * 50 + seq * 10 + hh], __float_as_uint(s2 * 1.02f));
      }
    } else {
      const float sc = d.kind == K_CQ ? QS_DIFF : 1.f;
      if (d.kind == K_CK) {
#pragma unroll
        for (int m = 0; m < 2; ++m) {
          float s2 = 0.f;
#pragma unroll
          for (int j = 0; j < 32; ++j) s2 += x[m * 32 + j] * x[m * 32 + j];
          s2 = wave_max(s2);
          if (lane == 0) atomicMax(&misc[layer * 50 + seq * 10 + 2 + (d.aux * 2 + hh) * 2 + m], __float_as_uint(s2 * 1.02f));
        }
      }
      rope32(x, tab, pos, sc);
      rope32(x + 32, tab, pos, sc);
    }
#pragma unroll
    for (int c = 0; c < 8; ++c) {
      u32x4 v;
#pragma unroll
      for (int i = 0; i < 4; ++i) v[i] = pack2bf(x[c * 8 + 2 * i], x[c * 8 + 2 * i + 1]);
      *(u32x4*)(row + c * 8) = v;
    }
  }
  __syncthreads();
}

constexpr int G_STAGE = 24576;
DI int gswz(int row, int lc) { return row * 32 + ((lc ^ ((row >> 2) & 3)) << 3); }

template <bool IN_PROJ>
DI void gemm_tile(const Params& p, int layer, int nt, int tt, char* smem) {
  int tid = tidx(p);
  asm volatile("" : "+v"(tid));
  const int w = __builtin_amdgcn_readfirstlane(tid >> 6), lane = tid & 63, r = lane & 31, h = lane >> 5;
  const int wf = w >> 1, wt = w & 1;
  const int n0 = nt * 256, t0 = tt * 128;
  const u16* Wt = IN_PROJ ? (const u16*)(p.ws + WS_WIN) + (size_t)layer * NCOL * DM
                          : (const u16*)(p.ws + WS_WOUT) + (size_t)layer * DM * DM;
  const u16* xb = (const u16*)(p.ws + WS_XB);
  const u16* mixA = (const u16*)(p.ws + WS_OF);
  const u16* mixB = (const u16*)(p.out + DO_BQ);
  const u16* mixC = (const u16*)(p.out + DO_CQ);

  f32x16 acc[4][2];
#pragma unroll
  for (int a = 0; a < 4; ++a)
#pragma unroll
    for (int b = 0; b < 2; ++b)
#pragma unroll
      for (int i = 0; i < 16; ++i) acc[a][b][i] = 0.f;

  typedef __attribute__((address_space(3))) void* lds_ptr_t;
  const __amdgpu_buffer_rsrc_t rA = __builtin_amdgcn_make_buffer_rsrc((void*)(Wt + (size_t)n0 * DM), 0, 0x7fffffff, 0x00020000);
  const __amdgpu_buffer_rsrc_t rB0 = __builtin_amdgcn_make_buffer_rsrc((void*)(IN_PROJ ? xb + (size_t)t0 * DM : mixA + (size_t)t0 * 512), 0, 0x7fffffff, 0x00020000);
  const __amdgpu_buffer_rsrc_t rB1 = __builtin_amdgcn_make_buffer_rsrc((void*)(mixB + (size_t)t0 * 256), 0, 0x7fffffff, 0x00020000);
  const __amdgpu_buffer_rsrc_t rB2 = __builtin_amdgcn_make_buffer_rsrc((void*)(mixC + (size_t)t0 * 256), 0, 0x7fffffff, 0x00020000);
  int voA[4], rowB[2], lcB[2];
#pragma unroll
  for (int i = 0; i < 4; ++i) { int c = tid + 256 * i; int row = c >> 2, lc = (c & 3) ^ ((row >> 2) & 3); voA[i] = row * (DM * 2) + lc * 16; }
#pragma unroll
  for (int i = 0; i < 2; ++i) { int c = tid + 256 * i; rowB[i] = c >> 2; lcB[i] = ((c & 3) ^ ((rowB[i] >> 2) & 3)) * 16; }
  auto stage = [&](int kt) {
    const int k0 = kt * 32;
    char* base = smem + (kt % 3) * G_STAGE + w * 1024;
#pragma unroll
    for (int i = 0; i < 4; ++i)
      __builtin_amdgcn_raw_ptr_buffer_load_lds(rA, (lds_ptr_t)(base + i * 4096), 16, voA[i], k0 * 2, 0, 0);
#pragma unroll
    for (int i = 0; i < 2; ++i) {
      lds_ptr_t dst = (lds_ptr_t)(base + 16384 + i * 4096);
      if (IN_PROJ) __builtin_amdgcn_raw_ptr_buffer_load_lds(rB0, dst, 16, rowB[i] * (DM * 2) + lcB[i], k0 * 2, 0, 0);
      else {
        if (k0 < 512) __builtin_amdgcn_raw_ptr_buffer_load_lds(rB0, dst, 16, rowB[i] * 1024 + lcB[i], k0 * 2, 0, 0);
        else if (k0 < 768) __builtin_amdgcn_raw_ptr_buffer_load_lds(rB1, dst, 16, rowB[i] * 512 + lcB[i], (k0 - 512) * 2, 0, 0);
        else __builtin_amdgcn_raw_ptr_buffer_load_lds(rB2, dst, 16, rowB[i] * 512 + lcB[i], (k0 - 768) * 2, 0, 0);
      }
    }
  };
  asm volatile("s_waitcnt vmcnt(0)" ::: "memory");
  __syncthreads();
  stage(0); stage(1); stage(2);
  auto load_frags = [&](int kt, int ks, bf16x8 (&fa)[4], bf16x8 (&fb)[2]) {
    const u16* sA = (const u16*)(smem + (kt % 3) * G_STAGE);
    const u16* sB = sA + 8192;
#pragma unroll
    for (int fi = 0; fi < 4; ++fi) fa[fi] = *(const bf16x8*)(sA + gswz(wf * 128 + fi * 32 + r, ks * 2 + h));
#pragma unroll
    for (int ti = 0; ti < 2; ++ti) fb[ti] = *(const bf16x8*)(sB + gswz(wt * 64 + ti * 32 + r, ks * 2 + h));
  };
  auto mma = [&](const bf16x8 (&fa)[4], const bf16x8 (&fb)[2]) {
#pragma unroll
    for (int fi = 0; fi < 4; ++fi)
#pragma unroll
      for (int ti = 0; ti < 2; ++ti) acc[fi][ti] = MFMA32(fa[fi], fb[ti], acc[fi][ti]);
  };
  bf16x8 fa0[4], fb0[2], fa1[4], fb1[2];
  asm volatile("s_waitcnt vmcnt(12)" ::: "memory");
  __syncthreads();
  load_frags(0, 0, fa0, fb0);
  for (int kt = 0; kt < 32; ++kt) {
    load_frags(kt, 1, fa1, fb1);
    mma(fa0, fb0);
    if (kt + 1 < 32) {
      if (kt + 2 < 32) asm volatile("s_waitcnt vmcnt(6) lgkmcnt(0)" ::: "memory");
      else asm volatile("s_waitcnt vmcnt(0) lgkmcnt(0)" ::: "memory");
      __syncthreads();
      if (kt + 3 < 32) stage(kt + 3);
      load_frags(kt + 1, 0, fa0, fb0);
    }
    mma(fa1, fb1);
  }
  __syncthreads();

  if (!IN_PROJ) {
    u16* yb = (u16*)(p.ws + WS_Y);
    u16* sC = (u16*)(smem + wf * 34816);
#pragma unroll
    for (int fi = 0; fi < 4; ++fi)
#pragma unroll
      for (int ti = 0; ti < 2; ++ti)
#pragma unroll
        for (int g = 0; g < 4; ++g) {
          u32x2 pk = {pack2bf(acc[fi][ti][4 * g], acc[fi][ti][4 * g + 1]), pack2bf(acc[fi][ti][4 * g + 2], acc[fi][ti][4 * g + 3])};
          *(u32x2*)(sC + (wt * 64 + ti * 32 + r) * CS + fi * 32 + 8 * g + 4 * h) = pk;
        }
    __syncthreads();
#pragma unroll
    for (int hf = 0; hf < 2; ++hf) {
      const u16* sH = (const u16*)(smem + hf * 34816);
#pragma unroll
      for (int i = 0; i < 8; ++i) {
        int c = tid + 256 * i; int row = c >> 4, cc = c & 15;
        u32x4 v = *(const u32x4*)(sH + row * CS + cc * 8);
        *(u32x4*)(yb + (size_t)(t0 + row) * DM + n0 + hf * 128 + cc * 8) = v;
      }
    }
    return;
  }

  const TileDesc d = tile_desc(p, nt * 2 + wf);
  const float* rstd = (const float*)(p.ws + WS_RSTD);
  u32* misc = (u32*)(p.ws + WS_MISC);
  const float* miscf = (const float*)misc;
  u16* sC = (u16*)(smem + wf * 34816);
#pragma unroll
  for (int ti = 0; ti < 2; ++ti) {
    const int t = t0 + wt * 64 + ti * 32 + r;
    const float rs = rstd[t];
#pragma unroll
    for (int fi = 0; fi < 4; ++fi)
#pragma unroll
      for (int i = 0; i < 16; ++i) acc[fi][ti][i] *= rs;
    if (d.kind == K_SILU) {
#pragma unroll
      for (int fi = 0; fi < 4; ++fi)
#pragma unroll
        for (int i = 0; i < 16; ++i) { float x = acc[fi][ti][i]; acc[fi][ti][i] = x * sigm(x); }
    } else if (d.kind == K_G) {
#pragma unroll
      for (int fi = 0; fi < 4; ++fi)
#pragma unroll
        for (int g = 0; g < 4; ++g) {
          float4 lb4 = make_float4(0.f, 0.f, 0.f, 0.f);
          if (layer != 0) lb4 = *(const float4*)(miscf + 128 + d.aux * 512 + d.col + fi * 32 + 8 * g + 4 * h);
          acc[fi][ti][4 * g] = __logf(lb4.x + (1.f - lb4.x) * sigm(acc[fi][ti][4 * g]));
          acc[fi][ti][4 * g + 1] = __logf(lb4.y + (1.f - lb4.y) * sigm(acc[fi][ti][4 * g + 1]));
          acc[fi][ti][4 * g + 2] = __logf(lb4.z + (1.f - lb4.z) * sigm(acc[fi][ti][4 * g + 2]));
          acc[fi][ti][4 * g + 3] = __logf(lb4.w + (1.f - lb4.w) * sigm(acc[fi][ti][4 * g + 3]));
        }
    }
    if (d.kind == K_VT) {
      const int rp = (r & ~12) | ((r & 4) << 1) | ((r & 8) >> 1);
#pragma unroll
      for (int fi = 0; fi < 4; ++fi)
#pragma unroll
        for (int i = 0; i < 16; ++i)
          sC[(fi * 32 + crow(i, h)) * CS + wt * 64 + ti * 32 + rp] = f2bf(acc[fi][ti][i]);
    } else {
#pragma unroll
      for (int fi = 0; fi < 4; ++fi)
#pragma unroll
        for (int g = 0; g < 4; ++g) {
          u32x2 pk;
          if (d.kind == K_G) {
            pk[0] = (u32)f2h(acc[fi][ti][4 * g]) | ((u32)f2h(acc[fi][ti][4 * g + 1]) << 16);
            pk[1] = (u32)f2h(acc[fi][ti][4 * g + 2]) | ((u32)f2h(acc[fi][ti][4 * g + 3]) << 16);
          } else {
            pk[0] = pack2bf(acc[fi][ti][4 * g], acc[fi][ti][4 * g + 1]);
            pk[1] = pack2bf(acc[fi][ti][4 * g + 2], acc[fi][ti][4 * g + 3]);
          }
          *(u32x2*)(sC + (wt * 64 + ti * 32 + r) * CS + fi * 32 + 8 * g + 4 * h) = pk;
        }
    }
  }
  __syncthreads();
  if (nt == 10 || nt == 11 || nt == 13 || nt == 14) qk_post(p, layer, nt, t0, tid, smem);
#pragma unroll
  for (int hf = 0; hf < 2; ++hf) {
    const TileDesc dd = tile_desc(p, nt * 2 + hf);
    const u16* sH = (const u16*)(smem + hf * 34816);
#pragma unroll
    for (int i = 0; i < 8; ++i) {
      int c = tid + 256 * i; int row = c >> 4, cc = c & 15;
      u32x4 v = *(const u32x4*)(sH + row * CS + cc * 8);
      if (dd.kind == K_VT) *(u32x4*)(dd.dst + (size_t)(dd.col + row) * T_TOK + t0 + cc * 8) = v;
      else *(u32x4*)(dd.dst + (size_t)(t0 + row) * dd.stride + dd.col + cc * 8) = v;
    }
  }
}

template <bool IN_PROJ>
DI void gemm_phase(const Params& p, int layer, char* smem) {
  constexpr int NT = IN_PROJ ? 17 : 4;
  constexpr int PER_XCD = 48 * NT;
  u32* ctr = (u32*)(p.ws + WS_MISC) + MISC_GCTR + layer * 16 + (IN_PROJ ? 0 : 8);
  int* s_tile = (int*)(smem + SMEM_BYTES - 16);
  const int x0 = (int)xcc_id() & 7;
  for (int a = 0; a < 8; ++a) {
    const int xq = (x0 + a) & 7;
    for (;;) {
      __syncthreads();
      if (tidx(p) == 0) *s_tile = (int)atomicAdd(ctr + xq, 1u);
      __syncthreads();
      const int q = __builtin_amdgcn_readfirstlane(*s_tile);
      if (q >= PER_XCD) break;
      int grp = q / (8 * NT), rem = q % (8 * NT);
      int nt = rem >> 3; int ttl = grp * 8 + (rem & 7);
      int tt = ttl * 8 + xq;
      gemm_tile<IN_PROJ>(p, layer, nt, tt, smem);
    }
  }
}


constexpr int HSEG = 128;
constexpr int H_UNITS = 96;

template <int PASS>
DI void hgrn_unit(const Params& p, int layer, int unit, char* smem) {
  int seq, grp, seg, nseg, ubase;
  if (unit < 32) { seq = 0; grp = unit >> 2; seg = unit & 3; nseg = 4; ubase = unit & ~3; }
  else { int u = unit - 32; seq = 1 + (u >> 4); grp = (u & 15) >> 1; seg = u & 1; nseg = 2; ubase = unit & ~1; }
  const int hd = grp >> 1, dir = grp & 1;
  const int seq_start = seq == 0 ? 0 : L_PROMPT + (seq - 1) * 8192;
  const int nch = nseg * HSEG;
  int tid = tidx(p);
  asm volatile("" : "+v"(tid));
  const int w = __builtin_amdgcn_readfirstlane(tid >> 6), lane = tid & 63, r = lane & 31, h = lane >> 5;
  const int d = tid & 127, half = tid >> 7;
  const u16* gq = (const u16*)(p.ws + WS_HQ) + hd * 128;
  const u16* gg = (const u16*)(p.ws + (dir ? WS_GB : WS_GF)) + hd * 128;
  const u16* gv = (const u16*)(p.ws + WS_HV) + hd * 128;
  u16* od = (u16*)(p.ws + (dir ? WS_OB : WS_OF));
  u16* sQm = (u16*)(smem + H_QM); u16* sKm = (u16*)(smem + H_KM); u16* sQb = (u16*)(smem + H_QB);
  u16* sKlT = (u16*)(smem + H_KLT); u16* sVt = (u16*)(smem + H_VT);
  float* sDec = (float*)(smem + H_DEC);
  float* HF = (float*)(p.ws + WS_HF); float* HD = (float*)(p.ws + WS_HD);
  u32* cnt = (u32*)(p.ws + WS_MISC) + MISC_HCNT + layer * 40 + seq * 8 + grp;

  f32x16 S[4];
#pragma unroll
  for (int b = 0; b < 4; ++b)
#pragma unroll
    for (int i = 0; i < 16; ++i) S[b][i] = 0.f;

  auto chunk_t0 = [&](int c) { return seq_start + (dir ? (nch - 1 - c) : c) * 32; };
  char* rawW = smem + H_RAW + w * 8192;
  const int dcol = (w & 1) * 64;
  auto gl = [&](int c) {
    const int t0 = chunk_t0(c);
    const int row8 = lane >> 3, ch = lane & 7;
#pragma unroll
    for (int i = 0; i < 4; ++i) {
      int j = 8 * i + row8;
      size_t off = (size_t)(dir ? t0 + 31 - j : t0 + j) * 512 + dcol + ch * 8;
      __builtin_amdgcn_global_load_lds((const unsigned*)(gg + off), (unsigned*)(rawW + i * 1024 + lane * 16), 16, 0, 0);
    }
#pragma unroll
    for (int i = 0; i < 2; ++i) {
      int j = half * 16 + 8 * i + row8;
      size_t off = (size_t)(dir ? t0 + 31 - j : t0 + j) * 512 + dcol + ch * 8;
      if (PASS == 2) __builtin_amdgcn_global_load_lds((const unsigned*)(gq + off), (unsigned*)(rawW + 4096 + i * 1024 + lane * 16), 16, 0, 0);
      __builtin_amdgcn_global_load_lds((const unsigned*)(gv + off), (unsigned*)(rawW + 6144 + i * 1024 + lane * 16), 16, 0, 0);
    }
  };
  const int c_begin = seg * HSEG, c_end = c_begin + HSEG;
  __syncthreads();
  gl(c_begin);
  if (PASS == 2 && seg > 0) {
    if (tid == 0) { while (__hip_atomic_load(cnt, __ATOMIC_RELAXED, __HIP_MEMORY_SCOPE_AGENT) < (u32)nseg) __builtin_amdgcn_s_sleep(8); }
    __syncthreads();
    __threadfence();
    for (int j = 0; j < seg; ++j) {
      const float* Fj = HF + ((size_t)(ubase + j) * 256 + tid) * 64;
      const float* Dj = HD + (size_t)(ubase + j) * 128;
#pragma unroll
      for (int db = 0; db < 4; ++db)
#pragma unroll
        for (int g = 0; g < 4; ++g) {
          float4 dc = *(const float4*)(Dj + db * 32 + 8 * g + 4 * h);
          float4 f = *(const float4*)(Fj + db * 16 + 4 * g);
          S[db][4 * g] = S[db][4 * g] * dc.x + f.x; S[db][4 * g + 1] = S[db][4 * g + 1] * dc.y + f.y;
          S[db][4 * g + 2] = S[db][4 * g + 2] * dc.z + f.z; S[db][4 * g + 3] = S[db][4 * g + 3] * dc.w + f.w;
        }
    }
  }
  float logD = 0.f;
  for (int c = c_begin; c < c_end; ++c) {
    const int t0 = chunk_t0(c);
    asm volatile("s_waitcnt vmcnt(0)" ::: "memory");
    const u16* rG = (const u16*)rawW; const u16* rQ = rG + 2048; const u16* rV = rG + 3072;
    float tot0 = 0.f, tot1 = 0.f, g16;
    float gval[16]; u16 qraw[16], vraw[16];
#pragma unroll
    for (int j = 0; j < 32; ++j) {
      float g = h2f(rG[j * 64 + lane]);
      if (j < 16) tot0 += g; else tot1 += g;
      if (j == 16) g16 = g;
      if ((j >> 4) == half) gval[j & 15] = g;
    }
#pragma unroll
    for (int jj = 0; jj < 16; ++jj) { if (PASS == 2) qraw[jj] = rQ[jj * 64 + lane]; vraw[jj] = rV[jj * 64 + lane]; }
    asm volatile("s_waitcnt lgkmcnt(0)" ::: "memory");
    __builtin_amdgcn_sched_barrier(0);
    if (c + 1 < c_end) gl(c + 1);
    __syncthreads();
    const float bmid = tot0 + g16, blast = tot0 + tot1;
    logD += blast;
    float run = half ? tot0 : 0.f;
    u32 klp[8], vtp[8];
    if (PASS == 2) {
      const float Emid = __expf(bmid), Elm = __expf(blast - bmid);
#pragma unroll
      for (int jj = 0; jj < 16; jj += 2) {
        float kl2[2];
#pragma unroll
        for (int u = 0; u < 2; ++u) {
          const int j = half * 16 + jj + u;
          run += gval[jj + u];
          float e1 = __expf(run - bmid), e2 = __expf(bmid - run);
          float q = bf2f(qraw[jj + u]);
          float k = 1.f - __expf(gval[jj + u]);
          float qm = q * e1, km = k * e2;
          kl2[u] = km * Elm;
          sQm[j * HS + d] = f2bf(qm); sKm[j * HS + d] = f2bf(km); sQb[j * HS + d] = f2bf(qm * Emid);
        }
        klp[jj >> 1] = pack2bf(kl2[0], kl2[1]);
      }
    } else {
#pragma unroll
      for (int jj = 0; jj < 16; jj += 2) {
        float kl2[2];
#pragma unroll
        for (int u = 0; u < 2; ++u) {
          run += gval[jj + u];
          kl2[u] = (1.f - __expf(gval[jj + u])) * __expf(blast - run);
        }
        klp[jj >> 1] = pack2bf(kl2[0], kl2[1]);
      }
    }
#pragma unroll
    for (int jj = 0; jj < 16; jj += 2)
      vtp[jj >> 1] = (u32)vraw[jj] | ((u32)vraw[jj + 1] << 16);
    {
      u32x4 a = {klp[0], klp[1], klp[2], klp[3]}, b = {klp[4], klp[5], klp[6], klp[7]};
      *(u32x4*)(sKlT + d * VS + half * 16) = a; *(u32x4*)(sKlT + d * VS + half * 16 + 8) = b;
      u32x4 c0 = {vtp[0], vtp[1], vtp[2], vtp[3]}, c1 = {vtp[4], vtp[5], vtp[6], vtp[7]};
      *(u32x4*)(sVt + d * VS + half * 16) = c0; *(u32x4*)(sVt + d * VS + half * 16 + 8) = c1;
    }
    if (half) sDec[d] = __expf(blast);
    __syncthreads();
    if (PASS == 2) {
      f32x16 at, oT;
#pragma unroll
      for (int i = 0; i < 16; ++i) { at[i] = 0.f; oT[i] = 0.f; }
#pragma unroll
      for (int ks = 0; ks < 8; ++ks) {
        bf16x8 a = *(const bf16x8*)(sKm + r * HS + ks * 16 + 8 * h);
        bf16x8 b = *(const bf16x8*)(sQm + r * HS + ks * 16 + 8 * h);
        at = MFMA32(a, b, at);
      }
#pragma unroll
      for (int i = 0; i < 16; ++i) if (crow(i, h) > r) at[i] = 0.f;
#pragma unroll
      for (int db = 0; db < 4; ++db)
#pragma unroll
        for (int s2 = 0; s2 < 2; ++s2) {
          bf16x8 a = pack8(S[db], s2);
          s16x4 lo = *(const s16x4*)(sQb + r * HS + db * 32 + s2 * 16 + 4 * h);
          s16x4 hi = *(const s16x4*)(sQb + r * HS + db * 32 + s2 * 16 + 8 + 4 * h);
          oT = MFMA32(a, cat44(lo, hi), oT);
        }
#pragma unroll
      for (int ks = 0; ks < 2; ++ks) {
        s16x4 lo = *(const s16x4*)(sVt + (32 * w + r) * VS + 16 * ks + 4 * h);
        s16x4 hi = *(const s16x4*)(sVt + (32 * w + r) * VS + 16 * ks + 8 + 4 * h);
        oT = MFMA32(cat44(lo, hi), pack8(at, ks), oT);
      }
      int tok = dir ? t0 + 31 - r : t0 + r;
#pragma unroll
      for (int g = 0; g < 4; ++g) {
        u32x2 pk = {pack2bf(oT[4 * g], oT[4 * g + 1]), pack2bf(oT[4 * g + 2], oT[4 * g + 3])};
        *(u32x2*)(od + (size_t)tok * 512 + hd * 128 + 32 * w + 8 * g + 4 * h) = pk;
      }
    }
    if (PASS == 1 || c + 1 < c_end) {
#pragma unroll
      for (int db = 0; db < 4; ++db) {
#pragma unroll
        for (int g = 0; g < 4; ++g) {
          float4 dc = *(const float4*)(sDec + db * 32 + 8 * g + 4 * h);
          S[db][4 * g] *= dc.x; S[db][4 * g + 1] *= dc.y; S[db][4 * g + 2] *= dc.z; S[db][4 * g + 3] *= dc.w;
        }
#pragma unroll
        for (int ks = 0; ks < 2; ++ks) {
          bf16x8 a = *(const bf16x8*)(sKlT + (db * 32 + r) * VS + 16 * ks + 8 * h);
          bf16x8 b = *(const bf16x8*)(sVt + (32 * w + r) * VS + 16 * ks + 8 * h);
          S[db] = MFMA32(a, b, S[db]);
        }
      }
    }
  }
  if (PASS == 1) {
    float* Fu = HF + ((size_t)unit * 256 + tid) * 64;
#pragma unroll
    for (int db = 0; db < 4; ++db)
#pragma unroll
      for (int g = 0; g < 4; ++g)
        *(float4*)(Fu + db * 16 + 4 * g) = make_float4(S[db][4 * g], S[db][4 * g + 1], S[db][4 * g + 2], S[db][4 * g + 3]);
    if (half == 0) HD[(size_t)unit * 128 + d] = __expf(logD);
    __threadfence();
    __syncthreads();
    if (tid == 0) atomicAdd(cnt, 1u);
  }
}

DI void hgrn_finalize(const Params& p, int layer) {
  const int wave = tidx(p) >> 6, lane = tidx(p) & 63;
  u16* of = (u16*)(p.ws + WS_OF); const u16* ob = (const u16*)(p.ws + WS_OB);
  const u16* ga = (const u16*)(p.out + DO_GA);
  const float* nw = p.hgrn_norm_w + layer * 512 + lane * 8;
  float wv[8];
#pragma unroll
  for (int i = 0; i < 8; ++i) wv[i] = nw[i];
  for (int t = blockIdx.x * 4 + wave; t < T_TOK; t += gridDim.x * 4) {
    size_t off = (size_t)t * 512 + lane * 8;
    u32x4 a = *(const u32x4*)(of + off), b = *(const u32x4*)(ob + off), g = *(const u32x4*)(ga + off);
    float v[8]; float ss = 0.f;
#pragma unroll
    for (int i = 0; i < 4; ++i) {
      v[2 * i] = bflo(a[i]) + bflo(b[i]); v[2 * i + 1] = bfhi(a[i]) + bfhi(b[i]);
      ss += v[2 * i] * v[2 * i] + v[2 * i + 1] * v[2 * i + 1];
    }
    ss += __shfl_xor(ss, 1); ss += __shfl_xor(ss, 2); ss += __shfl_xor(ss, 4); ss += __shfl_xor(ss, 8);
    float rn = rsqrtf(ss * (1.f / 128.f) + EPS);
    u32x4 o;
#pragma unroll
    for (int i = 0; i < 4; ++i)
      o[i] = pack2bf(v[2 * i] * rn * wv[2 * i] * bflo(g[i]), v[2 * i + 1] * rn * wv[2 * i + 1] * bfhi(g[i]));
    *(u32x4*)(of + off) = o;
  }
}

DI int swz(int row, int lc) { return row * 64 + ((lc ^ ((row >> 1) & 7)) << 3); }

template <int NKS>
DI void attn_tile(const Params& p, int layer, int seq, int slot, int qt, char* smem, bool wr = true) {
  int tid = tidx(p);
  asm volatile("" : "+v"(tid));
  const int w = __builtin_amdgcn_readfirstlane(tid >> 6), lane = tid & 63, r = lane & 31, h = lane >> 5;
  const int sub = w >> 1, qhalf = w & 1;
  const int seq_start = seq == 0 ? 0 : L_PROMPT + (seq - 1) * 8192;
  const int L = seq == 0 ? L_PROMPT : 8192;
  const int q0 = seq_start + qt * 128 + qhalf * 64;
  const u32* misc = (const u32*)(p.ws + WS_MISC);
  const float* miscf = (const float*)misc;
  constexpr bool GQA = (NKS == 4);
  const int hd = GQA ? (2 * slot + sub) : (slot - 2);
  u16* Qb; const u16* Kb; const u16* VT; int kstride, ks0, kslot;
  if (GQA) { Qb = (u16*)(p.out + DO_BQ) + hd * 64; Kb = (const u16*)(p.out + DO_BK) + slot * 64; kstride = 128;
             VT = (const u16*)(p.out + DO_BVT) + (size_t)(slot * 64) * T_TOK; ks0 = 0; kslot = slot; }
  else { Qb = (u16*)(p.out + DO_CQ) + hd * 64 + 32 * sub; Kb = (const u16*)(p.out + DO_CK) + hd * 64; kstride = 256;
         VT = (const u16*)(p.ws + WS_CVT) + (size_t)(hd * 64) * T_TOK; ks0 = 2 * sub; kslot = 2 + hd * 2 + sub; }
  const float kmax = sqrtf(__uint_as_float(misc[layer * 50 + seq * 10 + kslot]));

  bf16x8 qf[2][NKS]; float ncb[2], lsum[2];
  f32x16 O[2][2];
#pragma unroll
  for (int qb = 0; qb < 2; ++qb) {
    float ss = 0.f;
#pragma unroll
    for (int ks = 0; ks < NKS; ++ks) {
      u32x4 v = *(const u32x4*)(Qb + (size_t)(q0 + 32 * qb + r) * 256 + 16 * ks + 8 * h);
      qf[qb][ks] = __builtin_bit_cast(bf16x8, v);
#pragma unroll
      for (int i = 0; i < 4; ++i) { float a = bflo(v[i]), b = bfhi(v[i]); ss += a * a + b * b; }
    }
    ss += xhalf(ss);
    ncb[qb] = -sqrtf(ss) * kmax; lsum[qb] = 0.f;
#pragma unroll
    for (int eb = 0; eb < 2; ++eb)
#pragma unroll
      for (int i = 0; i < 16; ++i) O[qb][eb][i] = 0.f;
  }

  typedef __attribute__((address_space(3))) void* lds_ptr_t;
  const __amdgpu_buffer_rsrc_t rK = __builtin_amdgcn_make_buffer_rsrc((void*)Kb, 0, 0x7fffffff, 0x00020000);
  const __amdgpu_buffer_rsrc_t rV = __builtin_amdgcn_make_buffer_rsrc((void*)VT, 0, 0x7fffffff, 0x00020000);
  const int st_lc = ((tid & 7) ^ ((tid >> 4) & 7)) * 16;
  const int voK = (tid >> 3) * kstride * 2 + st_lc;
  const int voV = (tid >> 3) * (T_TOK * 2) + st_lc;
  auto stage = [&](int kt) {
    const int k0 = seq_start + kt * 128;
    char* base = smem + (kt & 1) * 32768 + w * 1024;
#pragma unroll
    for (int i = 0; i < 4; ++i) {
      __builtin_amdgcn_raw_ptr_buffer_load_lds(rK, (lds_ptr_t)(base + i * 4096), 16, voK, (k0 + 32 * i) * kstride * 2, 0, 0);
      __builtin_amdgcn_raw_ptr_buffer_load_lds(rV, (lds_ptr_t)(base + 16384 + i * 4096), 16, voV,
                                               (32 * (i & 1)) * (T_TOK * 2) + (k0 + 64 * (i >> 1)) * 2, 0, 0);
    }
  };
  const int nkt = L >> 7;
  const bool fast = wave_max(fmaxf(-ncb[0], -ncb[1])) < 60.f;
  f32x4m ls4[2];
#pragma unroll
  for (int qb = 0; qb < 2; ++qb)
#pragma unroll
    for (int i = 0; i < 4; ++i) ls4[qb][i] = 0.f;
  bf16x8 selA;
  {
    const int r16 = lane & 15, grp = lane >> 4;
    const short one = ((r16 == 0 && (grp & 1) == 0) || (r16 == 1 && (grp & 1) == 1)) ? (short)0x3F80 : (short)0;
#pragma unroll
    for (int i = 0; i < 8; ++i) selA[i] = one;
  }
  auto mainloop = [&](auto SUBT) {
    constexpr bool SUB = decltype(SUBT)::value;
    for (int kt = 0; kt < nkt; ++kt) {
      asm volatile("s_waitcnt vmcnt(0)" ::: "memory");
      __syncthreads();
      if (kt + 1 < nkt) stage(kt + 1);
#pragma unroll 1
      for (int kh = 0; kh < 2; ++kh) {
      const u16* sK = (const u16*)(smem + (kt & 1) * 32768 + kh * 8192);
      const u16* sV = (const u16*)(smem + (kt & 1) * 32768 + 16384 + kh * 8192);
      auto kb_body = [&](int kb) {
        bf16x8 kf[NKS];
#pragma unroll
        for (int ks = 0; ks < NKS; ++ks) kf[ks] = *(const bf16x8*)(sK + swz(32 * kb + r, 2 * (ks0 + ks) + h));
        bf16x8 pk[2][2];
#pragma unroll
        for (int qb = 0; qb < 2; ++qb) {
          f32x16 st;
#pragma unroll
          for (int i = 0; i < 16; ++i) st[i] = SUB ? ncb[qb] : 0.f;
#pragma unroll
          for (int ks = 0; ks < NKS; ++ks) st = MFMA32(kf[ks], qf[qb][ks], st);
          if constexpr (SUB) {
            float ls = 0.f;
#pragma unroll
            for (int i = 0; i < 16; ++i) { float e = __builtin_amdgcn_exp2f(st[i]); st[i] = e; ls = fadd1(ls, e); }
            lsum[qb] += ls;
            pk[qb][0] = pack8(st, 0); pk[qb][1] = pack8(st, 1);
          } else {
#pragma unroll
            for (int i = 0; i < 16; ++i) st[i] = __builtin_amdgcn_exp2f(st[i]);
            pk[qb][0] = pack8(st, 0); pk[qb][1] = pack8(st, 1);
            ls4[qb] = __builtin_amdgcn_mfma_f32_16x16x32_bf16(selA, pk[qb][0], ls4[qb], 0, 0, 0);
            ls4[qb] = __builtin_amdgcn_mfma_f32_16x16x32_bf16(selA, pk[qb][1], ls4[qb], 0, 0, 0);
          }
        }
#pragma unroll
        for (int eb = 0; eb < 2; ++eb)
#pragma unroll
          for (int s2 = 0; s2 < 2; ++s2) {
            bf16x8 vf = *(const bf16x8*)(sV + swz(32 * eb + r, 4 * kb + 2 * s2 + h));
#pragma unroll
            for (int qb = 0; qb < 2; ++qb) O[qb][eb] = MFMA32(vf, pk[qb][s2], O[qb][eb]);
          }
      };
      if constexpr (SUB) {
#pragma unroll 1
        for (int kb = 0; kb < 2; ++kb) kb_body(kb);
      } else {
        kb_body(0); kb_body(1);
      }
      }
    }
  };
  __syncthreads();
  stage(0);
  if (fast) mainloop(std::false_type{}); else mainloop(std::true_type{});
  if (fast) {
#pragma unroll
    for (int qb = 0; qb < 2; ++qb) {
      const float v0 = __shfl(ls4[qb][0], lane & 15), v1 = __shfl(ls4[qb][1], lane & 15);
      lsum[qb] = 0.5f * ((lane & 16) ? v1 : v0);
    }
  }
  __syncthreads();
  if (GQA) {
    const u16* gate = (const u16*)(p.out + DO_GB) + hd * 64;
#pragma unroll
    for (int qb = 0; qb < 2; ++qb) {
      const float inv = 1.f / (lsum[qb] + xhalf(lsum[qb]));
      const size_t t = (size_t)(q0 + 32 * qb + r);
#pragma unroll
      for (int eb = 0; eb < 2; ++eb)
#pragma unroll
        for (int g = 0; g < 4; ++g) {
          int e = 32 * eb + 8 * g + 4 * h;
          u32x2 gt = *(const u32x2*)(gate + t * 256 + e);
          u32x2 o = {pack2bf(O[qb][eb][4 * g] * inv * bflo(gt[0]), O[qb][eb][4 * g + 1] * inv * bfhi(gt[0])),
                     pack2bf(O[qb][eb][4 * g + 2] * inv * bflo(gt[1]), O[qb][eb][4 * g + 3] * inv * bfhi(gt[1]))};
          if (wr) *(u32x2*)(Qb + t * 256 + e) = o;
        }
    }
  } else {
    float* xch = (float*)smem;
    const float lam = miscf[104 + layer];
    const float post = 1.f - (0.8f - 0.6f * __expf(-0.3f * (float)layer));
    const u16* gate = (const u16*)(p.out + DO_GC) + hd * 64;
    u16* outb = (u16*)(p.out + DO_CQ) + hd * 64;
    const float* dnw = p.diff_norm_w + layer * 64;
#pragma unroll
    for (int qb = 0; qb < 2; ++qb) {
      const float inv = 1.f / (lsum[qb] + xhalf(lsum[qb]));
      if (sub == 1) {
#pragma unroll
        for (int eb = 0; eb < 2; ++eb)
#pragma unroll
          for (int i = 0; i < 16; ++i) xch[(qhalf * 32 + eb * 16 + i) * 64 + lane] = O[qb][eb][i] * inv;
      }
      __syncthreads();
      if (sub == 0) {
        float ss = 0.f;
#pragma unroll
        for (int eb = 0; eb < 2; ++eb)
#pragma unroll
          for (int i = 0; i < 16; ++i) {
            float v = O[qb][eb][i] * inv - lam * xch[(qhalf * 32 + eb * 16 + i) * 64 + lane];
            O[qb][eb][i] = v; ss += v * v;
          }
        ss += xhalf(ss);
        const float rn = rsqrtf(ss * (1.f / 64.f) + EPS) * post;
        const size_t t = (size_t)(q0 + 32 * qb + r);
#pragma unroll
        for (int eb = 0; eb < 2; ++eb)
#pragma unroll
          for (int g = 0; g < 4; ++g) {
            int e = 32 * eb + 8 * g + 4 * h;
            u32x2 gt = *(const u32x2*)(gate + t * 256 + e);
            float4 nw = *(const float4*)(dnw + e);
            u32x2 o = {pack2bf(O[qb][eb][4 * g] * rn * nw.x * bflo(gt[0]), O[qb][eb][4 * g + 1] * rn * nw.y * bfhi(gt[0])),
                       pack2bf(O[qb][eb][4 * g + 2] * rn * nw.z * bflo(gt[1]), O[qb][eb][4 * g + 3] * rn * nw.w * bfhi(gt[1]))};
            if (wr) *(u32x2*)(outb + t * 256 + e) = o;
          }
      }
      __syncthreads();
    }
  }
}

template <int NKS>
DI void attn_loop(const Params& p, int layer, char* smem, bool wr = true) {
  constexpr int NSLOT = NKS == 4 ? 2 : 4, SLOT0 = NKS == 4 ? 0 : 2;
  u32* ctr = (u32*)(p.ws + WS_MISC) + (wr ? 100 : MISC_HCNT + 90) + layer * 2 + (NKS == 4 ? 0 : 1);
  int* s_tile = (int*)(smem + SMEM_BYTES - 16);
  for (;;) {
    __syncthreads();
    if (tidx(p) == 0) *s_tile = (int)atomicAdd(ctr, 1u);
    __syncthreads();
    const int idx = __builtin_amdgcn_readfirstlane(*s_tile);
    if (idx >= NSLOT * 384) break;
    int seq, slot, qt;
    if (idx < NSLOT * 128) { seq = 0; slot = idx >> 7; qt = idx & 127; }
    else { int i2 = idx - NSLOT * 128; seq = 1 + i2 / (NSLOT * 64); int rem = i2 % (NSLOT * 64); slot = rem >> 6; qt = rem & 63; }
    attn_tile<NKS>(p, layer, seq, SLOT0 + slot, qt, smem, wr);
  }
}

DI void mixer_phase(const Params& p, int layer, char* smem) {
  for (int u = blockIdx.x; u < H_UNITS; u += gridDim.x) hgrn_unit<1>(p, layer, u, smem);
  for (int u = blockIdx.x; u < H_UNITS; u += gridDim.x) hgrn_unit<2>(p, layer, u, smem);
#ifdef PROBE_DUP_ATTN
  if (p.dry) { attn_loop<2>(p, layer, smem, false); attn_loop<4>(p, layer, smem, false); }
#endif
  attn_loop<4>(p, layer, smem);
  attn_loop<2>(p, layer, smem);
}

template <int PH>
DI void run_phase(const Params& p, char* smem) {
  if (PH == 0) { phase0(p, smem); return; }
  constexpr int layer = (PH - 1) / 5, s = (PH - 1) % 5;
  if (s == 0) { gemm_phase<true>(p, layer, smem);
#ifdef PROBE_DUP_GIN
    __syncthreads(); gemm_phase<true>(p, layer, smem);
#endif
  }
  else if (s == 1) mixer_phase(p, layer, smem);
  else if (s == 2) hgrn_finalize(p, layer);
  else if (s == 3) { gemm_phase<false>(p, layer, smem);
#ifdef PROBE_DUP_GOUT
    __syncthreads(); gemm_phase<false>(p, layer, smem);
#endif
  }
  else rowprep(p, layer == 0 ? 1 : 2);
}

DI void grid_barrier(const Params& p, unsigned k) {
  __syncthreads();
  if (tidx(p) == 0) {
    u32* bar = (u32*)(p.ws + WS_MISC) + MISC_BAR2;
    const unsigned g = blockIdx.x & 7u, gsize = gridDim.x >> 3;
    __threadfence();
    const unsigned t = __hip_atomic_fetch_add(bar + g * 64, 1u, __ATOMIC_RELAXED, __HIP_MEMORY_SCOPE_AGENT);
    if (t + 1 == k * gsize) {
      __hip_atomic_fetch_add(bar + 1024, 1u, __ATOMIC_RELAXED, __HIP_MEMORY_SCOPE_AGENT);
      while (__hip_atomic_load(bar + 1024, __ATOMIC_RELAXED, __HIP_MEMORY_SCOPE_AGENT) < 8u * k) __builtin_amdgcn_s_sleep(2);
      __hip_atomic_store(bar + 512 + g * 64, k, __ATOMIC_RELAXED, __HIP_MEMORY_SCOPE_AGENT);
    } else {
      while (__hip_atomic_load(bar + 512 + g * 64, __ATOMIC_RELAXED, __HIP_MEMORY_SCOPE_AGENT) < k) __builtin_amdgcn_s_sleep(2);
    }
    __threadfence();
  }
  __syncthreads();
}

#ifndef MULTI_LAUNCH
__global__ void __launch_bounds__(256, 2) hymba_mega(Params p0) {
  __shared__ __attribute__((aligned(16))) char smem[SMEM_BYTES];
  Params p = p0;
  p.wid = __builtin_amdgcn_readfirstlane(threadIdx.x >> 6);
  const unsigned nb = gridDim.x;
  run_phase<0>(p, smem); cg::this_grid().sync();
  run_phase<1>(p, smem); grid_barrier(p, 1);
  run_phase<2>(p, smem); grid_barrier(p, 2);
  run_phase<3>(p, smem); grid_barrier(p, 3);
  run_phase<4>(p, smem); grid_barrier(p, 4);
  run_phase<5>(p, smem); grid_barrier(p, 5);
  run_phase<6>(p, smem); grid_barrier(p, 6);
  run_phase<7>(p, smem); grid_barrier(p, 7);
  run_phase<8>(p, smem); grid_barrier(p, 8);
  run_phase<9>(p, smem); grid_barrier(p, 9);
  run_phase<10>(p, smem);
}
#else
template <int PH>
__global__ void __launch_bounds__(256, 2) hymba_phase(Params p0) {
  __shared__ __attribute__((aligned(16))) char smem[SMEM_BYTES];
  Params p = p0;
  p.wid = __builtin_amdgcn_readfirstlane(threadIdx.x >> 6);
  run_phase<PH>(p, smem);
}
#endif

extern "C" void kernel_launch(void* const* d_in, const int* in_sizes, int n_in, void* d_out, int out_size,
                              void* d_ws, size_t ws_size, hipStream_t stream) {
  static int grid_blocks = 0;
  if (!grid_blocks) {
    int dev = 0, cus = 0, per_cu = 2;
    (void)hipGetDevice(&dev);
    (void)hipDeviceGetAttribute(&cus, hipDeviceAttributeMultiprocessorCount, dev);
#ifndef MULTI_LAUNCH
    (void)hipOccupancyMaxActiveBlocksPerMultiprocessor(&per_cu, hymba_mega, 256, 0);
#endif
    if (per_cu > 2) per_cu = 2;
    if (per_cu < 1) per_cu = 1;
    grid_blocks = cus * per_cu;
  }
  Params p;
  memset(&p, 0, sizeof(p));
  p.x_prompt = (const float*)d_in[0]; p.x_sample = (const float*)d_in[1]; p.pre_norm_w = (const float*)d_in[2];
  p.w_in = (const float*)d_in[3]; p.hgrn_lb = (const float*)d_in[4]; p.hgrn_norm_w = (const float*)d_in[5];
  p.gqa_q_norm_w = (const float*)d_in[6]; p.gqa_k_norm_w = (const float*)d_in[7]; p.diff_lambda = (const float*)d_in[8];
  p.diff_norm_w = (const float*)d_in[9]; p.w_out = (const float*)d_in[10]; p.post_norm_w = (const float*)d_in[11];
  p.out = (char*)d_out; p.ws = (char*)d_ws;
#ifdef PROBE_DUP_ATTN
  p.dry = 1;
#endif
#ifndef MULTI_LAUNCH
  void* args[] = {&p};
  hipError_t e = hipLaunchCooperativeKernel((void*)hymba_mega, dim3(grid_blocks), dim3(256), args, 0, stream);
  if (e != hipSuccess) fprintf(stderr, "cooperative launch failed: %s (grid %d)\n", hipGetErrorString(e), grid_blocks);
#else
  dim3 g(grid_blocks), b(256);
  hymba_phase<0><<<g, b, 0, stream>>>(p); hymba_phase<1><<<g, b, 0, stream>>>(p); hymba_phase<2><<<g, b, 0, stream>>>(p);
  hymba_phase<3><<<g, b, 0, stream>>>(p); hymba_phase<4><<<g, b, 0, stream>>>(p); hymba_phase<5><<<g, b, 0, stream>>>(p);
  hymba_phase<6><<<g, b, 0, stream>>>(p); hymba_phase<7><<<g, b, 0, stream>>>(p); hymba_phase<8><<<g, b, 0, stream>>>(p);
  hymba_phase<9><<<g, b, 0, stream>>>(p); hymba_phase<10><<<g, b, 0, stream>>>(p);
#endif
}
```
